# Optimizing an MI355X kernel written in HIP

```python
import math
import jax
import jax.numpy as jnp
from jax import lax
import numpy as np

D_MODEL = 1024
BATCH = 8
SEQ = 4096
DEPTH = 4

N_EVEN = (DEPTH + 1) // 2
N_ODD = DEPTH // 2
RWKV_HEAD_DIM = 64
RWKV_WIDTH = D_MODEL // 2
RWKV_HEADS = RWKV_WIDTH // RWKV_HEAD_DIM
W_LORA = 64
A_LORA = 64
G_LORA = 128
LNX_EPS = 64e-5
A_PROJ = 3 * RWKV_WIDTH + W_LORA + A_LORA + G_LORA
RWKV_SPLITS = [RWKV_WIDTH, 2 * RWKV_WIDTH, 3 * RWKV_WIDTH, 3 * RWKV_WIDTH + W_LORA, 3 * RWKV_WIDTH + W_LORA + A_LORA]
CONV_WIDTH = D_MODEL - RWKV_WIDTH
CONV_KERNEL = 31
CONV_PAD = CONV_KERNEL // 2
CONV_GROUPS = 8
B_PROJ = 2 * CONV_WIDTH
AB_PROJ = A_PROJ + B_PROJ
ATTN_HEAD_DIM = 64
ATTN_HEADS = D_MODEL // ATTN_HEAD_DIM
ATTN_KV_HEADS = max(ATTN_HEADS // 8, 1)
ATTN_GROUP = ATTN_HEADS // ATTN_KV_HEADS
Q_WIDTH = ATTN_HEADS * ATTN_HEAD_DIM
KV_WIDTH = ATTN_KV_HEADS * ATTN_HEAD_DIM
WINDOW = 128
ATTN_BLOCK = 128
N_BUCKETS = 32
MAX_DISTANCE = 128
N_EXPERTS = 32
TOP_K = 4
EXPERT_FF = D_MODEL
SWIGLU_LIMIT = 7.0
SWIGLU_ALPHA = 1.702
EXPERT_BLOCK = 128
RMS_EPS = 1e-6
GN_EPS = 1e-5
NEG = -1e30

kernel_name = "hybrid_rwkv7_conformer_swa_moe_encoder"


def rms_norm(x, g):
    xf = x.astype(jnp.float32)
    y = xf * lax.rsqrt(jnp.mean(xf * xf, axis=-1, keepdims=True) + RMS_EPS)
    return (y * g).astype(x.dtype)


def group_norm(x, g, b, groups, eps):
    shp = x.shape
    xf = x.astype(jnp.float32).reshape(*shp[:-1], groups, shp[-1] // groups)
    mu = jnp.mean(xf, axis=-1, keepdims=True)
    xc = xf - mu
    var = jnp.mean(xc * xc, axis=-1, keepdims=True)
    y = (xc * lax.rsqrt(var + eps)).reshape(shp)
    return (y * g + b).astype(x.dtype)


def bidir_token_shift(p, mu_prev, mu_next):
    prev = jnp.pad(p, ((0, 0), (1, 0), (0, 0)))[:, :-1]
    nxt = jnp.pad(p, ((0, 0), (0, 1), (0, 0)))[:, 1:]
    return p + mu_prev * (prev - p) + mu_next * (nxt - p)


def wkv7_scan(r, w, k, v, a, b, reverse):
    bsz, _, h, n = r.shape
    xs = tuple(jnp.moveaxis(t, 1, 0) for t in (r, w, k, v, a, b))

    def step(state, inp):
        r_t, w_t, k_t, v_t, a_t, b_t = inp
        sa = jnp.einsum('bhvk,bhk->bhv', state, a_t)
        state = (state * w_t[:, :, None, :] + sa[..., None] * b_t[:, :, None, :]
                 + v_t[..., None] * k_t[:, :, None, :])
        return state, jnp.einsum('bhvk,bhk->bhv', state, r_t)

    s0 = jnp.zeros((bsz, h, n, n), jnp.float32)
    _, ys = lax.scan(step, s0, xs, reverse=reverse)
    return jnp.moveaxis(ys, 0, 1)


def rwkv7_time_mix(pa, w0, w2, a0, a2, k_k, k_a, r_k, lnx_g, lnx_b, g2):
    pa = pa.astype(jnp.float32)
    r, k, v, w_lo, a_lo, g_lo = jnp.split(pa, RWKV_SPLITS, axis=-1)
    bsz, s, _ = r.shape

    def heads(t):
        return t.reshape(bsz, s, RWKV_HEADS, RWKV_HEAD_DIM)

    rh, kh, vh = heads(r), heads(k), heads(v)
    kk = heads(k * k_k)
    kk = kk / jnp.maximum(jnp.sqrt(jnp.sum(kk * kk, axis=-1, keepdims=True)), 1e-12)
    k_a_h = k_a.reshape(RWKV_HEADS, RWKV_HEAD_DIM)
    tw = jnp.tanh(w_lo)
    wkv = jnp.zeros_like(rh)
    bonus = jnp.zeros_like(rh)
    for d in range(2):
        w_log = -jax.nn.softplus(-(w0[d] + tw @ w2[d])) - 0.5
        decay = heads(jnp.exp(-jnp.exp(w_log)))
        a = heads(jax.nn.sigmoid(a0[d] + a_lo @ a2[d]))
        k_d = kh * (1.0 + (a - 1.0) * k_a_h)
        wkv = wkv + wkv7_scan(rh, decay, k_d, vh, -kk, kk * a, reverse=(d == 1))
        bonus = bonus + jnp.sum(rh * k_d * r_k, axis=-1, keepdims=True) * vh
    y = group_norm(wkv.reshape(bsz, s, RWKV_WIDTH), lnx_g, lnx_b, RWKV_HEADS, LNX_EPS)
    y = y + bonus.reshape(bsz, s, RWKV_WIDTH)
    g = jax.nn.sigmoid(g_lo) @ g2
    return y * g


def conformer_conv(pb, conv_w, conv_b, gn_g, gn_b):
    u, gate = jnp.split(pb, 2, axis=-1)
    hcv = u * jax.nn.sigmoid(gate)
    kern = conv_w[:, None, :].astype(hcv.dtype)
    hcv = lax.conv_general_dilated(hcv, kern, window_strides=(1,), padding=((CONV_PAD, CONV_PAD),),
                                   dimension_numbers=('NWC', 'WIO', 'NWC'),
                                   feature_group_count=CONV_WIDTH) + conv_b
    hcv = group_norm(hcv, gn_g, gn_b, CONV_GROUPS, GN_EPS)
    return jax.nn.silu(hcv)


def t5_bucket(rel):
    n = -rel
    half = N_BUCKETS // 2
    ret = jnp.where(n < 0, half, 0)
    n = jnp.abs(n)
    max_exact = half // 2
    nf = jnp.maximum(n, 1).astype(jnp.float32)
    large = max_exact + (jnp.log(nf / max_exact) / math.log(MAX_DISTANCE / max_exact)
                         * (half - max_exact)).astype(jnp.int32)
    large = jnp.minimum(large, half - 1)
    return ret + jnp.where(n < max_exact, n, large)


def banded_window_attention(q, k, v, sink, rel_bias):
    bsz, s, kvh, grp, dh = q.shape
    nb = s // ATTN_BLOCK
    qb = jnp.moveaxis(q.reshape(bsz, nb, ATTN_BLOCK, kvh, grp, dh), 1, 0)
    pad = ((0, 0), (ATTN_BLOCK, ATTN_BLOCK), (0, 0), (0, 0))
    kp = jnp.pad(k, pad).reshape(bsz, nb + 2, ATTN_BLOCK, kvh, dh)
    vp = jnp.pad(v, pad).reshape(bsz, nb + 2, ATTN_BLOCK, kvh, dh)
    rel = jnp.arange(3 * ATTN_BLOCK)[None, :] - ATTN_BLOCK - jnp.arange(ATTN_BLOCK)[:, None]
    bias = jnp.transpose(rel_bias[t5_bucket(rel)].astype(jnp.float32), (2, 0, 1))
    bias = jnp.where(jnp.abs(rel) <= WINDOW, bias, NEG).reshape(kvh, grp, ATTN_BLOCK, 3 * ATTN_BLOCK)
    sink_b = sink.astype(jnp.float32).reshape(1, kvh, grp, 1, 1)
    scale = ATTN_HEAD_DIM ** -0.5

    def block(args):
        qblk, i = args
        kblk = lax.dynamic_slice_in_dim(kp, i, 3, axis=1).reshape(bsz, 3 * ATTN_BLOCK, kvh, dh)
        vblk = lax.dynamic_slice_in_dim(vp, i, 3, axis=1).reshape(bsz, 3 * ATTN_BLOCK, kvh, dh)
        sc = jnp.einsum('bqkgd,bjkd->bkgqj', qblk, kblk).astype(jnp.float32) * scale + bias
        key_pos = (i - 1) * ATTN_BLOCK + jnp.arange(3 * ATTN_BLOCK)
        valid = (key_pos >= 0) & (key_pos < s)
        sc = jnp.where(valid, sc, NEG)
        m = jnp.maximum(jnp.max(sc, axis=-1, keepdims=True), sink_b)
        p = jnp.exp(sc - m)
        denom = jnp.sum(p, axis=-1, keepdims=True) + jnp.exp(sink_b - m)
        o = jnp.einsum('bkgqj,bjkd->bkgqd', p, vblk.astype(jnp.float32)) / denom
        return jnp.transpose(o, (0, 3, 1, 2, 4))

    out = lax.map(block, (qb, jnp.arange(nb)))
    return jnp.moveaxis(out, 0, 1).reshape(bsz, s, kvh * grp * dh).astype(q.dtype)


def moe_ffn(h, router_w, router_b, w1, b1, w2, b2):
    bsz, s, d = h.shape
    t = bsz * s
    xt = h.reshape(t, d)
    logits = (xt @ router_w + router_b).astype(jnp.float32)
    top_val, top_idx = lax.top_k(logits, TOP_K)
    gates = jax.nn.softmax(top_val, axis=-1)
    n_assign = t * TOP_K
    e_flat = top_idx.reshape(n_assign)
    tok_flat = jnp.arange(n_assign) // TOP_K
    g_flat = gates.reshape(n_assign)
    order = jnp.argsort(e_flat, stable=True)
    e_sorted = e_flat[order]
    counts = jnp.bincount(e_flat, length=N_EXPERTS)
    group_start = jnp.cumsum(counts) - counts
    padded = ((counts + EXPERT_BLOCK - 1) // EXPERT_BLOCK) * EXPERT_BLOCK
    padded_end = jnp.cumsum(padded)
    padded_start = padded_end - padded
    dest = padded_start[e_sorted] + (jnp.arange(n_assign) - group_start[e_sorted])
    n_slots = n_assign + N_EXPERTS * EXPERT_BLOCK
    n_blocks = n_slots // EXPERT_BLOCK
    slot_tok = jnp.full((n_slots,), t, jnp.int32).at[dest].set(tok_flat[order].astype(jnp.int32))
    slot_gate = jnp.zeros((n_slots,), jnp.float32).at[dest].set(g_flat[order])
    blk_expert = jnp.minimum(jnp.searchsorted(padded_end, jnp.arange(n_blocks) * EXPERT_BLOCK, side='right'),
                             N_EXPERTS - 1)
    x_pad = jnp.concatenate([xt, jnp.zeros((1, d), xt.dtype)], axis=0)
    xs = x_pad[slot_tok].reshape(n_blocks, EXPERT_BLOCK, d)

    def expert_block(args):
        xb, e = args
        hcat = xb @ w1[e] + b1[e]
        x_glu = jnp.minimum(hcat[:, 0::2], SWIGLU_LIMIT)
        x_lin = jnp.clip(hcat[:, 1::2], -SWIGLU_LIMIT, SWIGLU_LIMIT)
        act = x_glu * jax.nn.sigmoid(SWIGLU_ALPHA * x_glu) * (x_lin + 1.0)
        return act @ w2[e] + b2[e]

    ys = lax.map(expert_block, (xs, blk_expert)).reshape(n_slots, d)
    ys = ys * slot_gate[:, None]
    out = jax.ops.segment_sum(ys, slot_tok, num_segments=t + 1)[:t]
    return out.reshape(bsz, s, d).astype(h.dtype)


def setup_inputs(seed: int = 0) -> dict:
    key = jax.random.key(seed)
    ks = iter(jax.random.split(key, 64))
    f32 = jnp.float32
    D = D_MODEL
    NE, NO = N_EVEN, N_ODD

    def nrm(shape, scale):
        return jax.random.normal(next(ks), shape, f32) * scale

    def uni(shape, lo, hi):
        return jax.random.uniform(next(ks), shape, f32, lo, hi)

    return {
        "x": nrm((BATCH, SEQ, D), 1.0),
        "c": nrm((BATCH, D), 1.0),
        "mod_w": nrm((DEPTH, D, 6 * D), 0.3 * D ** -0.5),
        "mod_b": nrm((DEPTH, 6 * D), 0.1),
        "norm_mix_pre": 1.0 + nrm((DEPTH, D), 0.05),
        "norm_mix_post": 1.0 + nrm((DEPTH, D), 0.05),
        "norm_ffn_pre": 1.0 + nrm((DEPTH, D), 0.05),
        "norm_ffn_post": 1.0 + nrm((DEPTH, D), 0.05),
        "ab_w_in": nrm((NE, D, AB_PROJ), D ** -0.5),
        "ab_mu_prev": uni((NE, A_PROJ), 0.0, 0.5),
        "ab_mu_next": uni((NE, A_PROJ), 0.0, 0.5),
        "rwkv_w0": uni((NE, 2, RWKV_WIDTH), -6.0, -1.0),
        "rwkv_w2": nrm((NE, 2, W_LORA, RWKV_WIDTH), 0.1 * W_LORA ** -0.5),
        "rwkv_a0": nrm((NE, 2, RWKV_WIDTH), 0.5),
        "rwkv_a2": nrm((NE, 2, A_LORA, RWKV_WIDTH), 0.1 * A_LORA ** -0.5),
        "rwkv_k_k": 0.85 + nrm((NE, RWKV_WIDTH), 0.05),
        "rwkv_k_a": 1.0 + nrm((NE, RWKV_WIDTH), 0.05),
        "rwkv_r_k": nrm((NE, RWKV_HEADS, RWKV_HEAD_DIM), 0.1),
        "rwkv_lnx_g": 1.0 + nrm((NE, RWKV_WIDTH), 0.05),
        "rwkv_lnx_b": nrm((NE, RWKV_WIDTH), 0.02),
        "rwkv_g2": nrm((NE, G_LORA, RWKV_WIDTH), G_LORA ** -0.5),
        "conv_w": nrm((NE, CONV_KERNEL, CONV_WIDTH), CONV_KERNEL ** -0.5),
        "conv_b": nrm((NE, CONV_WIDTH), 0.02),
        "conv_gn_g": 1.0 + nrm((NE, CONV_WIDTH), 0.05),
        "conv_gn_b": nrm((NE, CONV_WIDTH), 0.02),
        "ab_w_out": nrm((NE, RWKV_WIDTH + CONV_WIDTH, D), (RWKV_WIDTH + CONV_WIDTH) ** -0.5),
        "attn_w_qkv": nrm((NO, D, Q_WIDTH + 2 * KV_WIDTH), D ** -0.5),
        "attn_sink": nrm((NO, ATTN_HEADS), 0.5),
        "attn_w_o": nrm((NO, Q_WIDTH, D), Q_WIDTH ** -0.5),
        "rel_bias": nrm((N_BUCKETS, ATTN_HEADS), 0.5),
        "router_w": nrm((DEPTH, D, N_EXPERTS), D ** -0.5),
        "router_b": nrm((DEPTH, N_EXPERTS), 0.01),
        "exp_w1": nrm((DEPTH, N_EXPERTS, D, 2 * EXPERT_FF), D ** -0.5),
        "exp_b1": nrm((DEPTH, N_EXPERTS, 2 * EXPERT_FF), 0.01),
        "exp_w2": nrm((DEPTH, N_EXPERTS, EXPERT_FF, D), EXPERT_FF ** -0.5),
        "exp_b2": nrm((DEPTH, N_EXPERTS, D), 0.01),
    }


def reference(x, c, mod_w, mod_b, norm_mix_pre, norm_mix_post, norm_ffn_pre, norm_ffn_post,
              ab_w_in, ab_mu_prev, ab_mu_next, rwkv_w0, rwkv_w2, rwkv_a0, rwkv_a2, rwkv_k_k, rwkv_k_a,
              rwkv_r_k, rwkv_lnx_g, rwkv_lnx_b, rwkv_g2, conv_w, conv_b, conv_gn_g, conv_gn_b, ab_w_out,
              attn_w_qkv, attn_sink, attn_w_o, rel_bias,
              router_w, router_b, exp_w1, exp_b1, exp_w2, exp_b2):
    bsz, s, _ = x.shape
    c_act = jax.nn.silu(c)
    for layer in range(DEPTH):
        j = layer // 2
        mod = (c_act @ mod_w[layer] + mod_b[layer])[:, None, :]
        sh1, sc1, gt1, sh2, sc2, gt2 = jnp.split(mod, 6, axis=-1)
        h = rms_norm(x, norm_mix_pre[layer]) * (1.0 + sc1) + sh1
        if layer % 2 == 0:
            p = h @ ab_w_in[j]
            pa = bidir_token_shift(p[..., :A_PROJ], ab_mu_prev[j], ab_mu_next[j])
            ya = rwkv7_time_mix(pa, rwkv_w0[j], rwkv_w2[j], rwkv_a0[j], rwkv_a2[j], rwkv_k_k[j],
                                rwkv_k_a[j], rwkv_r_k[j], rwkv_lnx_g[j], rwkv_lnx_b[j], rwkv_g2[j])
            yb = conformer_conv(p[..., A_PROJ:], conv_w[j], conv_b[j], conv_gn_g[j], conv_gn_b[j])
            y = jnp.concatenate([ya.astype(h.dtype), yb.astype(h.dtype)], axis=-1) @ ab_w_out[j]
        else:
            qkv = h @ attn_w_qkv[j]
            q, k, v = jnp.split(qkv, [Q_WIDTH, Q_WIDTH + KV_WIDTH], axis=-1)
            q = q.reshape(bsz, s, ATTN_KV_HEADS, ATTN_GROUP, ATTN_HEAD_DIM)
            k = k.reshape(bsz, s, ATTN_KV_HEADS, ATTN_HEAD_DIM)
            v = v.reshape(bsz, s, ATTN_KV_HEADS, ATTN_HEAD_DIM)
            y = banded_window_attention(q, k, v, attn_sink[j], rel_bias) @ attn_w_o[j]
        x = x + gt1 * rms_norm(y, norm_mix_post[layer])
        h = rms_norm(x, norm_ffn_pre[layer]) * (1.0 + sc2) + sh2
        y = moe_ffn(h, router_w[layer], router_b[layer], exp_w1[layer], exp_b1[layer],
                    exp_w2[layer], exp_b2[layer])
        x = x + gt2 * rms_norm(y, norm_ffn_post[layer])
    return x
```

```cpp
#include <hip/hip_runtime.h>
#include <cstdio>
#include <cstdint>

#define GAS __attribute__((address_space(1)))
#define LAS __attribute__((address_space(3)))
#define CAS __attribute__((address_space(4)))
#define DI __device__ __forceinline__

typedef unsigned short bf16_t;
typedef short bf16x8 __attribute__((ext_vector_type(8)));
typedef short s16x4 __attribute__((ext_vector_type(4)));
typedef float f32x2 __attribute__((ext_vector_type(2)));
typedef float f32x4 __attribute__((ext_vector_type(4)));
typedef float f32x16 __attribute__((ext_vector_type(16)));
typedef unsigned u32x2 __attribute__((ext_vector_type(2)));
typedef unsigned u32x4 __attribute__((ext_vector_type(4)));
typedef int i32x4 __attribute__((ext_vector_type(4)));
typedef int i32x8 __attribute__((ext_vector_type(8)));

constexpr int NB = 8, SEQ = 4096, D = 1024, T = NB * SEQ, DEPTH = 4;
constexpr int RW = 512, RH = 8, A_PROJ = 1792, AB_PROJ = 2816, LORA_N = 2560, LORA_K = 256;
constexpr int QKV_N = 1280, NE = 32, FF = 1024;
constexpr int NCH = 16, CHL = SEQ / NCH;
constexpr int NSEQ = NB * RH * 2;
constexpr int MAX_TILES = 544, MAX_SLOTS = MAX_TILES * 256;
constexpr int NWAVES = 8, NTHR = 512;

constexpr size_t MiB = 1u << 20;
constexpr size_t WS_CTL = 0, CTL_ZERO_BYTES = 1 * MiB;
constexpr int CW_BAR = 4096;
constexpr int CW_GCNT = 16384;
constexpr size_t WS_MOD = 1 * MiB;
constexpr size_t WS_RWT = 2 * MiB;
constexpr size_t WS_B1P = 3 * MiB;
constexpr size_t WS_TOKE = 4 * MiB;
constexpr size_t WS_TOKP = 5 * MiB;
constexpr size_t WS_TOKG = 6 * MiB;
constexpr size_t WS_TOKS = 7 * MiB;
constexpr size_t WS_SLOTTOK = 40 * MiB;
constexpr size_t WS_WLORA = 8 * MiB;
constexpr size_t WS_WIN = 12 * MiB;
constexpr size_t WS_WOUT = 24 * MiB;
constexpr size_t WS_WQKV = 28 * MiB;
constexpr size_t WS_WO = 34 * MiB;
constexpr size_t WS_W1 = 64 * MiB;
constexpr size_t WS_W2 = 576 * MiB;
constexpr size_t WS_H = 832 * MiB;
constexpr size_t WS_P = 896 * MiB;
constexpr size_t WS_LIN = 1072 * MiB;
constexpr size_t WS_LO = 1088 * MiB;
constexpr size_t WS_RS = 1248 * MiB;
constexpr size_t WS_RD = 1440 * MiB;
constexpr size_t WS_BS = 1824 * MiB;
constexpr size_t WS_YL = 1952 * MiB;
constexpr size_t WS_ZZ = 2080 * MiB;
constexpr size_t WS_GL = 2208 * MiB;
constexpr size_t WS_UL = 2240 * MiB;
constexpr size_t WS_SS = 2272 * MiB;
constexpr size_t WS_YAB = 2304 * MiB;
constexpr size_t WS_Y = 2368 * MiB;
constexpr size_t WS_XS = 2432 * MiB;
constexpr size_t WS_A1 = 2704 * MiB;
constexpr size_t WS_SC2 = 2976 * MiB;
constexpr size_t SC2_RS = 0, SC2_RD = 192 * MiB, SC2_ZZ = 576 * MiB, SC2_GL = 704 * MiB;
constexpr size_t WS_XB = 3712 * MiB;
constexpr size_t WS_H8 = 3776 * MiB;
constexpr size_t WS_END = 3808 * MiB;

constexpr int RING_BYTES = 131072;
constexpr int LDSCTL_OFF = RING_BYTES;
constexpr int L_MISC = LDSCTL_OFF;
constexpr int L_HIST = LDSCTL_OFF + 256;
constexpr int L_BASE = LDSCTL_OFF + 384;
constexpr int L_PSTART = LDSCTL_OFF + 512;
constexpr int L_NTILES = LDSCTL_OFF + 704;
constexpr int L_CNT = LDSCTL_OFF + 768;
constexpr int L_TILEE = LDSCTL_OFF + 1024;
constexpr int LDS_BYTES = 147456;

DI float bf2f(unsigned v) { return __builtin_bit_cast(float, v << 16); }
DI float kf(float c) { asm volatile("" : "+v"(c)); return c; }
DI int ki(int c) { asm volatile("" : "+v"(c)); return c; }
DI int shfl_src(int x, int src_lane) { return __builtin_amdgcn_ds_bpermute(src_lane << 2, x); }
DI unsigned f2bf(float f) { unsigned u = __builtin_bit_cast(unsigned, f); return (u + 0x7fffu + ((u >> 16) & 1u)) >> 16; }
DI unsigned pk2(float lo, float hi) { return f2bf(lo) | (f2bf(hi) << 16); }
typedef __bf16 bfv2_ __attribute__((ext_vector_type(2)));
DI unsigned cvtb2(float lo, float hi) { return __builtin_bit_cast(unsigned, __builtin_convertvector((f32x2){lo, hi}, bfv2_)); }
DI unsigned cvt_pk_bf16(float lo, float hi) { unsigned r; asm volatile("v_cvt_pk_bf16_f32 %0, %1, %2" : "=v"(r) : "v"(lo), "v"(hi)); return r; }
#define DPP_ADD(x, ctrl) ((x) + __builtin_bit_cast(float, __builtin_amdgcn_update_dpp(0, __builtin_bit_cast(int, (x)), (ctrl), 0xf, 0xf, true)))
DI unsigned pk_fp8x4(float a, float b, float c, float d) { int p = 0; p = __builtin_amdgcn_cvt_pk_fp8_f32(a, b, p, false); p = __builtin_amdgcn_cvt_pk_fp8_f32(c, d, p, true); return (unsigned)p; }
constexpr float W8_SCALE = 64.f;
DI float wave_sum(float v) {
    v = DPP_ADD(v, 0xB1); v = DPP_ADD(v, 0x4E); v = DPP_ADD(v, 0x141); v = DPP_ADD(v, 0x140);
    const int vi = __builtin_bit_cast(int, v);
    return (__builtin_bit_cast(float, __builtin_amdgcn_readlane(vi, 0)) + __builtin_bit_cast(float, __builtin_amdgcn_readlane(vi, 16))) + (__builtin_bit_cast(float, __builtin_amdgcn_readlane(vi, 32)) + __builtin_bit_cast(float, __builtin_amdgcn_readlane(vi, 48)));
}
DI float sigmoidf_(float x) { return __builtin_amdgcn_rcpf(1.f + __expf(-x)); }
DI float tanhf_(float x) { return 1.f - 2.f * __builtin_amdgcn_rcpf(1.f + __expf(2.f * x)); }
DI const CAS float* as_const(const float* p) { return (const CAS float*)(unsigned long long)p; }
#define LDS_WAIT() asm volatile("s_waitcnt lgkmcnt(0)" ::: "memory")
#define VM_WAIT() asm volatile("s_waitcnt vmcnt(0)" ::: "memory")

#define XB_TMO      128
#define XB_XCNT(j)  (256  + 64 * (j))
#define XB_XSUB(j)  (1280 + 64 * (j))
#define XB_XGEN(j)  (2304 + 64 * (j))
#define XB_TOP      3328
#define XB_TOPGEN   3392
#define XCD_BAR_WORDS 3456
#define XB_SPIN_CAP (1u << 18)
DI unsigned xb_ld(unsigned* p)              { return __hip_atomic_load(p, __ATOMIC_RELAXED, __HIP_MEMORY_SCOPE_AGENT); }
DI unsigned xb_add(unsigned* p, unsigned v) { return __hip_atomic_fetch_add(p, v, __ATOMIC_RELAXED, __HIP_MEMORY_SCOPE_AGENT); }
DI unsigned xb_xcc_id() { return (unsigned)__builtin_amdgcn_s_getreg((3 << 11) | 20) & 0xFu; }
#define XB_SPIN(cond, bar) do { unsigned _sp = 0; while (cond) { __builtin_amdgcn_s_sleep(1); \
    if ((++_sp & 255u) == 0u) { if (xb_ld(&(bar)[XB_TMO])) break; if (_sp > XB_SPIN_CAP) { atomicAdd(&(bar)[XB_TMO], 1u); break; } } } } while (0)
struct XcdBarrier { unsigned* bar; unsigned x; volatile LAS unsigned* st; };
DI XcdBarrier xcd_barrier_post(unsigned* bar, volatile LAS unsigned* st, const bool leader) {
    XcdBarrier b; b.bar = bar; b.x = xb_xcc_id(); b.st = st;
    if (leader) (void)xb_add(&bar[XB_XCNT(b.x)], 1u);
    return b;
}
DI void xcd_barrier_complete(unsigned* bar, unsigned x, unsigned& nloc, unsigned& nx) {
    const unsigned G = gridDim.x * gridDim.y * gridDim.z;
    unsigned sum, cnt, mine, sp = 0u;
    for (;;) {
        sum = 0u; cnt = 0u; mine = 0u;
#pragma unroll
        for (unsigned j = 0; j < 16; ++j) { const unsigned c = xb_ld(&bar[XB_XCNT(j)]); sum += c; cnt += (c > 0u) ? 1u : 0u; mine = (j == x) ? c : mine; }
        if (sum == G) break;
        __builtin_amdgcn_s_sleep(1);
        if ((++sp & 255u) == 0u) { if (xb_ld(&bar[XB_TMO])) break; if (sp > XB_SPIN_CAP) { atomicAdd(&bar[XB_TMO], 1u); break; } }
    }
    nloc = mine > 0u ? mine : 1u; nx = cnt > 0u ? cnt : 1u;
}
DI void xcd_barrier(const XcdBarrier& b, const bool leader) {
    asm volatile("s_waitcnt vmcnt(0)" ::: "memory");
    __syncthreads();
    if (leader) {
        unsigned* bar = b.bar;
        __builtin_amdgcn_s_waitcnt(0);
        unsigned nloc = b.st[0], nx = b.st[1];
        if (nloc == 0u) { xcd_barrier_complete(bar, b.x, nloc, nx); b.st[0] = nloc; b.st[1] = nx; }
        const unsigned old = xb_add(&bar[XB_XSUB(b.x)], 1u);
        const unsigned gen = old / nloc;
        if (old + 1u == (gen + 1u) * nloc) {
            __builtin_amdgcn_fence(__ATOMIC_RELEASE, "agent");
            asm volatile("s_waitcnt vmcnt(0)" ::: "memory");
            const unsigned og = xb_add(&bar[XB_TOP], 1u);
            const unsigned tg = og / nx;
            if (og + 1u == (tg + 1u) * nx) xb_add(&bar[XB_TOPGEN], 1u);
            else XB_SPIN(xb_ld(&bar[XB_TOPGEN]) == tg, bar);
            __builtin_amdgcn_fence(__ATOMIC_ACQUIRE, "agent");
            xb_add(&bar[XB_XGEN(b.x)], 1u);
            asm volatile("s_waitcnt vmcnt(0)" ::: "memory");
        } else {
            XB_SPIN(xb_ld(&bar[XB_XGEN(b.x)]) == gen, bar);
            __builtin_amdgcn_fence(__ATOMIC_ACQUIRE, "agent");
            asm volatile("s_waitcnt vmcnt(0)" ::: "memory");
        }
    }
    __syncthreads();
}

namespace pg8 {
constexpr int BM = 256, BK = 64, HALF = 128, HTB = HALF * BK * 2, STAGE_BYTES = 8 * HTB, NXCD = 8, WGM = 8;
__host__ __device__ __forceinline__ int lds_byte(int r, int c) { const int st = (r >> 4) * 2 + (c >> 5), rr = r & 15, cc = c & 31, ob = rr * 64 + cc * 2; return st * 1024 + (ob ^ (((ob >> 9) & 1) << 5)); }
__host__ __device__ __forceinline__ void stage_rc(int b, int& R, int& C) { const int st = b / 1024, sb = b % 1024, swz = sb ^ (((sb >> 9) & 1) << 5); R = (st >> 1) * 16 + swz / 64; C = (st & 1) * 32 + (swz % 64) / 2; }
__host__ __device__ __forceinline__ int perm32(int rho) { const int n = rho >> 4, i = rho & 15; return 8 * (i >> 2) + 4 * n + (i & 3); }

struct Unit { int pm, pn, pb, e; };
struct Gemm { const bf16_t* A; const bf16_t* Bt; int K; };

struct TileOrder {
    int nM, nN, nwg, G, c, wgm; const LAS int* tile_e;
    DI void init(int nM_, int nN_, int G_, int c_, const LAS int* te) { nM = nM_; nN = nN_; nwg = nM * nN; G = G_; c = c_; tile_e = te; wgm = (32 + nN / 2) / nN; if (wgm < 1) wgm = 1; }
    DI bool next(int i, Unit& u) const {
        const long L = (long)i * G + c; if (L >= nwg) return false;
        int wgid = (int)L; { const int q = nwg / NXCD, r = nwg % NXCD, xcd = wgid % NXCD, off = wgid / NXCD; wgid = (xcd < r ? xcd * (q + 1) : r * (q + 1) + (xcd - r) * q) + off; }
        const int nig = wgm * nN, gid = wgid / nig, fm = gid * wgm, gsz = (nM - fm) < wgm ? (nM - fm) : wgm;
        u.pm = fm + ((wgid % nig) % gsz); u.pn = (wgid % nig) / gsz;
        if (tile_e) { u.e = __builtin_amdgcn_readfirstlane(tile_e[u.pm]); u.pb = u.e * nN + u.pn; } else { u.e = 0; u.pb = u.pn; }
        return true;
    }
};

template <class P> DI void acc_init_from(f32x4 (&acc)[2][2][4][2], P bp, const float bscale) {
    f32x4 bv[2][2];
#pragma unroll
    for (int bj = 0; bj < 2; ++bj)
#pragma unroll
        for (int n = 0; n < 2; ++n) bv[bj][n] = bp[(bj * HALF + 4 * n) / 4] * bscale;
#pragma unroll
    for (int a = 0; a < 2; ++a)
#pragma unroll
        for (int b = 0; b < 2; ++b)
#pragma unroll
            for (int m = 0; m < 4; ++m)
#pragma unroll
                for (int n = 0; n < 2; ++n) acc[a][b][m][n] = bv[b][n];
}
DI void acc_zero(f32x4 (&acc)[2][2][4][2]) {
#pragma unroll
    for (int a = 0; a < 2; ++a)
#pragma unroll
        for (int b = 0; b < 2; ++b)
#pragma unroll
            for (int m = 0; m < 4; ++m)
#pragma unroll
                for (int n = 0; n < 2; ++n) acc[a][b][m][n] = (f32x4){0.f, 0.f, 0.f, 0.f};
}
template <bool HAS_BIAS> struct EpiBf16 {
    static constexpr bool PERM = true;
    static constexpr float OSCALE = 1.f;
    bf16_t* O; int ldc; const float* bias; int bias_stride;
    static constexpr bool HASB = HAS_BIAS;
    DI const float* bias_ptr(const Unit& u) const { return bias + (size_t)u.e * bias_stride + u.pn * BM; }
    DI void operator()(const f32x4 (&acc)[2][2][4][2], const Unit& u, int wr, int wc, int fr, int fq) const {
        const int row0 = u.pm * BM + wr * 64 + fr; const int col0 = u.pn * BM + wc * 32 + 8 * fq;
#pragma unroll
        for (int ai = 0; ai < 2; ++ai)
#pragma unroll
            for (int m = 0; m < 4; ++m) { bf16_t* rowp = O + (size_t)(row0 + ai * HALF + m * 16) * ldc + col0;
#pragma unroll
                for (int bj = 0; bj < 2; ++bj) { const f32x4 v0 = acc[ai][bj][m][0], v1 = acc[ai][bj][m][1];
                    u32x4 w; w.x = cvtb2(v0[0], v0[1]); w.y = cvtb2(v0[2], v0[3]); w.z = cvtb2(v1[0], v1[1]); w.w = cvtb2(v1[2], v1[3]);
                    *(u32x4*)(rowp + bj * HALF) = w; } }
    }
};
template <bool HAS_BIAS> struct EpiF8 {
    static constexpr bool PERM = true;
    static constexpr float OSCALE = 16.f;
    unsigned char* O; int ldc; const float* bias; int bias_stride;
    static constexpr bool HASB = HAS_BIAS;
    DI const float* bias_ptr(const Unit& u) const { return bias + (size_t)u.e * bias_stride + u.pn * BM; }
    DI void operator()(const f32x4 (&acc)[2][2][4][2], const Unit& u, int wr, int wc, int fr, int fq) const {
        const int row0 = u.pm * BM + wr * 64 + fr; const int col0 = u.pn * BM + wc * 32 + 8 * (fq & ~1) + (fq & 1) * HALF; const float cmax = kf(448.f);
#pragma unroll
        for (int ai = 0; ai < 2; ++ai)
#pragma unroll
            for (int m = 0; m < 4; ++m) { unsigned char* rowp = O + (size_t)(row0 + ai * HALF + m * 16) * ldc + col0;
                u32x2 w[2];
#pragma unroll
                for (int bj = 0; bj < 2; ++bj) { f32x4 v0 = acc[ai][bj][m][0], v1 = acc[ai][bj][m][1];
#pragma unroll
                    for (int i = 0; i < 4; ++i) { v0[i] = __builtin_amdgcn_fmed3f(v0[i], -cmax, cmax); v1[i] = __builtin_amdgcn_fmed3f(v1[i], -cmax, cmax); }
                    w[bj].x = pk_fp8x4(v0[0], v0[1], v0[2], v0[3]); w[bj].y = pk_fp8x4(v1[0], v1[1], v1[2], v1[3]); }
                const u32x2 sx = __builtin_amdgcn_permlane16_swap(w[0].x, w[1].x, false, false), sy = __builtin_amdgcn_permlane16_swap(w[0].y, w[1].y, false, false);
                *(u32x4*)rowp = (u32x4){sx.x, sy.x, sx.y, sy.y}; }
    }
};
struct EpiSwiglu {
    static constexpr bool PERM = true;
    static constexpr float OSCALE = 1.f;
    unsigned char* O; int ldc; const float* bias; int bias_stride;
    static constexpr bool HASB = true;
    DI const float* bias_ptr(const Unit& u) const { return bias + (size_t)u.e * bias_stride + u.pn * BM; }
    DI void operator()(const f32x4 (&acc)[2][2][4][2], const Unit& u, int wr, int wc, int fr, int fq) const {
        const int row0 = u.pm * BM + wr * 64 + fr + (fq & 1) * 16; const int col0 = u.pn * HALF + wc * 32 + 8 * (fq & ~1); const float c7 = kf(7.f);
#pragma unroll
        for (int ai = 0; ai < 2; ++ai)
#pragma unroll
            for (int mp = 0; mp < 2; ++mp) { unsigned char* rowp = O + (size_t)(row0 + ai * HALF + mp * 32) * ldc + col0;
                u32x2 w[2];
#pragma unroll
                for (int mm = 0; mm < 2; ++mm) { const int m = 2 * mp + mm; float o[8];
#pragma unroll
                    for (int n = 0; n < 2; ++n) { const f32x4 g = acc[ai][0][m][n], l = acc[ai][1][m][n];
#pragma unroll
                        for (int jp = 0; jp < 2; ++jp) {
                            const f32x2 xg = __builtin_elementwise_min((f32x2){g[2 * jp], g[2 * jp + 1]}, (f32x2){c7, c7});
                            const f32x2 xl = __builtin_elementwise_min(__builtin_elementwise_max((f32x2){l[2 * jp], l[2 * jp + 1]}, (f32x2){-c7, -c7}), (f32x2){c7, c7});
                            const f32x2 z = xg * (-1.702f * 1.44269504f); f32x2 e; e.x = __builtin_amdgcn_exp2f(z.x); e.y = __builtin_amdgcn_exp2f(z.y);
                            const f32x2 dn = e + 1.f; f32x2 rc; rc.x = __builtin_amdgcn_rcpf(dn.x); rc.y = __builtin_amdgcn_rcpf(dn.y);
                            const f32x2 r2 = (xg * rc) * (xl + 1.f); o[n * 4 + 2 * jp] = r2.x; o[n * 4 + 2 * jp + 1] = r2.y; } }
                    w[mm].x = pk_fp8x4(o[0], o[1], o[2], o[3]); w[mm].y = pk_fp8x4(o[4], o[5], o[6], o[7]); }
                const u32x2 sx = __builtin_amdgcn_permlane16_swap(w[0].x, w[1].x, false, false), sy = __builtin_amdgcn_permlane16_swap(w[0].y, w[1].y, false, false);
                *(u32x4*)rowp = (u32x4){sx.x, sy.x, sx.y, sy.y}; }
    }
};

constexpr int CAPX = 32768;
struct GatherInfo { const int* slot_tok; const LAS int* cnt; const LAS int* pstart; };
DI void gather_offs_direct(const GatherInfo& GI, const Unit& u, int tid, int K, unsigned (&o0)[2], unsigned (&o1)[2]) {
    const int e = u.e, lt = u.pm - (__builtin_amdgcn_readfirstlane(GI.pstart[e]) >> 8), cnt = __builtin_amdgcn_readfirstlane(GI.cnt[e]);
    const int* st = GI.slot_tok + (size_t)e * CAPX;
#pragma unroll
    for (int i = 0; i < 2; ++i) { int R, C; stage_rc(tid * 16 + i * 8192, R, C);
        const int r0 = lt * 256 + R, r1 = r0 + HALF; const int t0 = st[r0 < cnt ? r0 : 0], t1 = st[r1 < cnt ? r1 : 0];
        o0[i] = (unsigned)((r0 < cnt ? t0 : 0) * K + C) * 2u; o1[i] = (unsigned)((r1 < cnt ? t1 : 0) * K + C) * 2u; }
}
DI void gather_issue(const GatherInfo& GI, const Unit& u, int wid, int lane, LAS unsigned char* idx) {
    if (wid < 4) { const int e = u.e, lt = u.pm - (__builtin_amdgcn_readfirstlane(GI.pstart[e]) >> 8);
        __builtin_amdgcn_global_load_lds((const unsigned*)(GI.slot_tok + (size_t)e * CAPX + lt * 256 + wid * 64 + lane), (LAS unsigned*)(idx + wid * 256), 4, 0, 0); }
}
DI void gather_offs_lds(const GatherInfo& GI, const Unit& u, int tid, int K, const LAS unsigned char* idx, unsigned (&o0)[2], unsigned (&o1)[2]) {
    const int e = u.e, lt = u.pm - (__builtin_amdgcn_readfirstlane(GI.pstart[e]) >> 8), cnt = __builtin_amdgcn_readfirstlane(GI.cnt[e]);
#pragma unroll
    for (int i = 0; i < 2; ++i) { int R, C; stage_rc(tid * 16 + i * 8192, R, C);
        const int r0 = lt * 256 + R, r1 = r0 + HALF; const int t0 = *(const LAS int*)(idx + R * 4), t1 = *(const LAS int*)(idx + (HALF + R) * 4);
        o0[i] = (unsigned)((r0 < cnt ? t0 : 0) * K + C) * 2u; o1[i] = (unsigned)((r1 < cnt ? t1 : 0) * K + C) * 2u; }
}
DI void tile_offs(const Unit& u, int tid, int K, unsigned (&o0)[2], unsigned (&o1)[2]) {
#pragma unroll
    for (int i = 0; i < 2; ++i) { int R, C; stage_rc(tid * 16 + i * 8192, R, C);
        o0[i] = (unsigned)((u.pm * 256 + R) * K + C) * 2u; o1[i] = (unsigned)((u.pm * 256 + HALF + R) * K + C) * 2u; }
}
template <class Epi, int GATHER = 0, bool FP8 = false, int SCALE_A = 0x79797979>
DI void gemm_phase(LAS unsigned char* lds, const int tid_in, const Gemm g, const TileOrder& S, const Epi& E, const GatherInfo GI = GatherInfo{nullptr, nullptr, nullptr}) {
    int tid = tid_in; asm volatile("" : "+v"(tid));
    const int wid = __builtin_amdgcn_readfirstlane(tid >> 6), lane = tid & 63, wr = wid >> 2, wc = wid & 3, fr = lane & 15, fq = lane >> 4;
    const int K = g.K, nt = K / BK;
    unsigned vA0[2], vA1[2], voffB[2];
    const size_t kstep = (size_t)(BK * 2);
    const size_t hstep = (size_t)HALF * K * 2;
#pragma unroll
    for (int i = 0; i < 2; ++i) { int R, C; stage_rc(tid * 16 + i * 8192, R, C); const int Rb = Epi::PERM ? ((R & ~31) + perm32(R & 31)) : R;
        vA0[i] = (unsigned)(R * K + C) * 2u; vA1[i] = vA0[i] + (unsigned)hstep; voffB[i] = (unsigned)(Rb * K + C) * 2u; }
    const size_t tstep = 2 * hstep;
    const unsigned ldsw = (unsigned)wid * 1024u;
    const int aoff = lds_byte(wr * 64 + fr, fq * 8), boff = lds_byte(wc * 32 + fr, fq * 8);
#define PG8_SA(b, h) (((b) * 2 + (h)) * HTB)
#define PG8_SB(b, h) ((4 + (b) * 2 + (h)) * HTB)
#define PG8_STAGE(bufoff, gbase, voff) do { _Pragma("unroll") for (int _i = 0; _i < 2; ++_i) \
        __builtin_amdgcn_global_load_lds((const unsigned*)((const char*)(gbase) + (voff)[_i]), (LAS unsigned*)(lds + (bufoff) + ldsw + _i * 8192), 16, 0, 0); } while (0)
#define PG8_LDA(dst, b, h) do { _Pragma("unroll") for (int m = 0; m < 4; ++m) _Pragma("unroll") for (int k = 0; k < 2; ++k) dst[m][k] = *(const LAS bf16x8*)(lds + PG8_SA(b, h) + aoff + m * 2048 + k * 1024); } while (0)
#define PG8_LDB(dst, b, h) do { _Pragma("unroll") for (int n = 0; n < 2; ++n) _Pragma("unroll") for (int k = 0; k < 2; ++k) dst[n][k] = *(const LAS bf16x8*)(lds + PG8_SB(b, h) + boff + n * 2048 + k * 1024); } while (0)
#define PG8_MMA(ai, bj, At, Bt) do { __builtin_amdgcn_sched_barrier(0); __builtin_amdgcn_s_setprio(1); _Pragma("unroll") for (int m = 0; m < 4; ++m) _Pragma("unroll") for (int n = 0; n < 2; ++n) { \
        if constexpr (FP8) acc[ai][bj][m][n] = __builtin_amdgcn_mfma_scale_f32_16x16x128_f8f6f4(__builtin_shufflevector(__builtin_bit_cast(i32x4, Bt[n][0]), __builtin_bit_cast(i32x4, Bt[n][1]), 0, 1, 2, 3, 4, 5, 6, 7), \
                __builtin_shufflevector(__builtin_bit_cast(i32x4, At[m][0]), __builtin_bit_cast(i32x4, At[m][1]), 0, 1, 2, 3, 4, 5, 6, 7), acc[ai][bj][m][n], 0, 0, 0, sc_w, 0, sc_a); \
        else { _Pragma("unroll") for (int k = 0; k < 2; ++k) acc[ai][bj][m][n] = __builtin_amdgcn_mfma_f32_16x16x32_bf16(Bt[n][k], At[m][k], acc[ai][bj][m][n], 0, 0, 0); } } \
        __builtin_amdgcn_s_setprio(0); __builtin_amdgcn_sched_barrier(0); } while (0)
#define PG8_WAIT_V(n) asm volatile("s_waitcnt vmcnt(" #n ")" ::: "memory")
#define PG8_WAIT_L(n) asm volatile("s_waitcnt lgkmcnt(" #n ")" ::: "memory")
#define PG8_BAR __builtin_amdgcn_s_barrier()
#define PG8_SCHED __builtin_amdgcn_sched_barrier(0)
    const int sc_w = ki(SCALE_A), sc_a = ki(0x7f7f7f7f);
    Unit cur, nxt; int ui = 0;
    if (!S.next(0, cur)) return;
    f32x4 acc[2][2][4][2];
    if constexpr (Epi::HASB) acc_init_from(acc, (const f32x4*)(E.bias_ptr(cur) + wc * 32 + 8 * fq), Epi::OSCALE); else acc_zero(acc);
    bf16x8 At[4][2], B0[2][2], B1[2][2];
    const char* cA = GATHER ? (const char*)g.A : (const char*)g.A + (size_t)cur.pm * tstep;
    if constexpr (GATHER == 2) tile_offs(cur, tid, K, vA0, vA1); const char* cB = (const char*)g.Bt + (size_t)cur.pb * tstep;
    LAS unsigned char* utab = lds + STAGE_BYTES + 4096;
    if constexpr (GATHER == 1) gather_offs_direct(GI, cur, tid, K, vA0, vA1);
    PG8_STAGE(PG8_SB(0, 0), cB, voffB); PG8_STAGE(PG8_SB(0, 1), cB + hstep, voffB); PG8_STAGE(PG8_SA(0, 0), cA, vA0); PG8_STAGE(PG8_SA(0, 1), cA, vA1);
    if (wr == 1) PG8_BAR;
    PG8_WAIT_V(2); PG8_BAR;
    PG8_STAGE(PG8_SB(1, 0), cB + kstep, voffB); PG8_STAGE(PG8_SA(1, 0), cA + kstep, vA0); PG8_STAGE(PG8_SB(1, 1), cB + hstep + kstep, voffB);
    PG8_WAIT_V(6); PG8_BAR;
    for (;;) {
        const bool has_next = S.next(ui + 1, nxt);
        const char* nA = GATHER ? cA : (has_next ? (const char*)g.A + (size_t)nxt.pm * tstep : cA); const char* nB = has_next ? (const char*)g.Bt + (size_t)nxt.pb * tstep : cB;
        LAS unsigned char* ntab = utab + ((ui + 1) & 1) * 2048;
        if constexpr (GATHER == 1) { if (has_next) gather_issue(GI, nxt, wid, lane, ntab); }
        if constexpr (Epi::HASB) { if (has_next && wid >= 4) __builtin_amdgcn_global_load_lds((const unsigned*)(E.bias_ptr(nxt) + (wid - 4) * 64 + lane), (LAS unsigned*)(ntab + 1024 + (wid - 4) * 256), 4, 0, 0); }
        for (int t = 0; t < nt; t += 2) {
            const bool last = (t == nt - 2);
            const char* a1 = cA + (size_t)(t + 1) * kstep;
            const char* a2 = last ? nA : cA + (size_t)(t + 2) * kstep; const char* b2 = last ? nB : cB + (size_t)(t + 2) * kstep;
            const char* a3 = a2 + kstep; const char* b3 = b2 + kstep;
            PG8_LDB(B0, 0, 0); PG8_LDB(B1, 0, 1); PG8_SCHED; PG8_LDA(At, 0, 0); PG8_STAGE(PG8_SA(1, 1), a1, vA1);
            if constexpr (GATHER == 1) { if (last && has_next) gather_offs_lds(GI, nxt, tid, K, ntab, vA0, vA1); }
            if constexpr (GATHER == 2) { if (last && has_next) tile_offs(nxt, tid, K, vA0, vA1); }
            PG8_WAIT_V(8); PG8_WAIT_L(0); PG8_BAR; PG8_MMA(0, 0, At, B0); PG8_MMA(0, 1, At, B1); PG8_BAR; PG8_SCHED;
            PG8_LDA(At, 0, 1); PG8_STAGE(PG8_SB(0, 0), b2, voffB); PG8_STAGE(PG8_SB(0, 1), b2 + hstep, voffB); PG8_STAGE(PG8_SA(0, 0), a2, vA0);
            PG8_WAIT_V(8); PG8_WAIT_L(0); PG8_BAR; PG8_MMA(1, 0, At, B0); PG8_MMA(1, 1, At, B1); PG8_BAR; PG8_SCHED;
            PG8_LDB(B0, 1, 0); PG8_LDB(B1, 1, 1); PG8_SCHED; PG8_LDA(At, 1, 0); PG8_STAGE(PG8_SA(0, 1), a2, vA1);
            PG8_WAIT_V(8); PG8_WAIT_L(0); PG8_BAR; PG8_MMA(0, 0, At, B0); PG8_MMA(0, 1, At, B1); PG8_BAR; PG8_SCHED;
            PG8_LDA(At, 1, 1); PG8_STAGE(PG8_SB(1, 0), b3, voffB); PG8_STAGE(PG8_SB(1, 1), b3 + hstep, voffB); PG8_STAGE(PG8_SA(1, 0), a3, vA0);
            PG8_WAIT_V(8); PG8_WAIT_L(0); PG8_BAR; PG8_MMA(1, 0, At, B0); PG8_MMA(1, 1, At, B1); PG8_BAR; PG8_SCHED;
        }
        if (wr == 0) PG8_BAR;
        { int l2; asm volatile("v_mbcnt_lo_u32_b32 %0, -1, 0\n\tv_mbcnt_hi_u32_b32 %0, -1, %0" : "=v"(l2)); E(acc, cur, wr, wc, l2 & 15, l2 >> 4); }
        if (!has_next) break;
        if constexpr (Epi::HASB) acc_init_from(acc, (const LAS f32x4*)(ntab + 1024 + (wc * 32 + 8 * fq) * 4), Epi::OSCALE); else acc_zero(acc);
        cur = nxt; cA = nA; cB = nB; ++ui;
        if (wr == 1) PG8_BAR;
    }
    PG8_WAIT_V(0);
    PG8_BAR;
#undef PG8_SA
#undef PG8_SB
#undef PG8_STAGE
#undef PG8_LDA
#undef PG8_LDB
#undef PG8_MMA
#undef PG8_WAIT_V
#undef PG8_WAIT_L
#undef PG8_BAR
#undef PG8_SCHED
}
}

struct Args { const float* in[36]; float* out; unsigned char* ws; int ph_lo, ph_hi; };

struct Frame {
    const CAS Args* ap;
    LAS unsigned char* lds;
    int tid, lane, wave, vcu, G, gw, NGW;
    unsigned char* ws;
};

DI int tid_now(const int wv) { int t; asm volatile("v_mbcnt_lo_u32_b32 %0, -1, 0\n\tv_mbcnt_hi_u32_b32 %0, -1, %0" : "=v"(t)); return t + wv * 64; }
DI Frame make_frame(LAS unsigned char* lds, const int wv) {
    Frame F; { const CAS Args* ap = (const CAS Args*)__builtin_amdgcn_kernarg_segment_ptr(); asm volatile("" : "+s"(ap)); F.ap = ap; } int t; asm volatile("v_mbcnt_lo_u32_b32 %0, -1, 0\n\tv_mbcnt_hi_u32_b32 %0, -1, %0" : "=v"(t)); t += wv * 64; int bx = blockIdx.x; asm volatile("" : "+s"(bx)); int G = gridDim.x; asm volatile("" : "+s"(G));
    F.lds = lds; F.tid = t; F.lane = t & 63; F.wave = __builtin_amdgcn_readfirstlane(t >> 6);
    F.G = G; F.vcu = (G % 8 == 0) ? (bx % 8) * (G / 8) + bx / 8 : bx;
    F.gw = F.vcu * NWAVES + F.wave; F.NGW = G * NWAVES; F.ws = F.ap->ws;
    return F;
}
DI int w1_row(int n) { const int o = n >> 1; return 256 * (o >> 7) + 128 * (n & 1) + (o & 127); }
DI void transpose_item(const float* W, int K, int N, bf16_t* WT, int mode, LAS float* scr, int item, int lane) {
    const int nblk = N / 32, kb = item / nblk, nb = item % nblk, k0 = 64 * kb, n0 = 32 * nb;
    { const int rr = lane >> 3, c4 = lane & 7; f32x4 v[8];
#pragma unroll
      for (int i = 0; i < 8; ++i) v[i] = *(const f32x4*)(W + (size_t)(k0 + 8 * i + rr) * N + n0 + 4 * c4);
#pragma unroll
      for (int i = 0; i < 8; ++i) { LAS float* d = scr + (8 * i + rr) * 33 + 4 * c4; d[0] = v[i].x; d[1] = v[i].y; d[2] = v[i].z; d[3] = v[i].w; } }
    LDS_WAIT(); asm volatile("" ::: "memory");
    const int c = lane & 7;
#pragma unroll
    for (int j = 0; j < 4; ++j) { const int n = (lane >> 3) + 8 * j; const LAS float* s = scr + (8 * c) * 33 + n;
        const int row = (mode & 1) ? w1_row(n0 + n) : (n0 + n);
        if (mode & 2) { u32x2 o; o.x = pk_fp8x4(s[0 * 33] * W8_SCALE, s[1 * 33] * W8_SCALE, s[2 * 33] * W8_SCALE, s[3 * 33] * W8_SCALE); o.y = pk_fp8x4(s[4 * 33] * W8_SCALE, s[5 * 33] * W8_SCALE, s[6 * 33] * W8_SCALE, s[7 * 33] * W8_SCALE);
            *(u32x2*)((unsigned char*)WT + (size_t)row * K + k0 + 8 * c) = o; }
        else { u32x4 o; o.x = pk2(s[0 * 33], s[1 * 33]); o.y = pk2(s[2 * 33], s[3 * 33]); o.z = pk2(s[4 * 33], s[5 * 33]); o.w = pk2(s[6 * 33], s[7 * 33]);
            *(u32x4*)(WT + (size_t)row * K + k0 + 8 * c) = o; } }
    LDS_WAIT(); asm volatile("" ::: "memory");
}

DI void phase_expert_weights(const Frame& F, int l, int which) {
    LAS float* scr = (LAS float*)(F.lds + F.wave * 16384);
    unsigned char* ws = F.ws;
    if (which == 0) {
        constexpr int IPM = (D / 64) * (2048 / 32);
        for (int it = F.gw; it < NE * IPM; it += F.NGW) { const int mtx = l * NE + it / IPM, r = it % IPM;
            transpose_item(F.ap->in[32] + (size_t)mtx * D * 2048, D, 2048, (bf16_t*)(ws + WS_W1 + (size_t)mtx * 2048 * D), 3, scr, r, F.lane); }
    }
    else {
        constexpr int IPM = (FF / 64) * (D / 32);
        for (int it = F.gw; it < NE * IPM; it += F.NGW) { const int mtx = l * NE + it / IPM, r = it % IPM;
            transpose_item(F.ap->in[34] + (size_t)mtx * FF * D, FF, D, (bf16_t*)(ws + WS_W2 + (size_t)mtx * D * FF), 2, scr, r, F.lane); }
    }
}
DI void phase_prologue(const Frame& F) {
    LAS float* scr = (LAS float*)(F.lds + F.wave * 16384);
    unsigned char* ws = F.ws;
    {
        constexpr int IPM = (D / 64) * (AB_PROJ / 32);
        for (int it = F.gw; it < 2 * IPM; it += F.NGW) { const int mtx = it / IPM, r = it % IPM;
            transpose_item(F.ap->in[8] + (size_t)mtx * D * AB_PROJ, D, AB_PROJ, (bf16_t*)(ws + WS_WIN + (size_t)mtx * AB_PROJ * D), 2, scr, r, F.lane); }
    }
    {
        constexpr int IPM = (D / 64) * (D / 32);
        for (int it = F.gw; it < 2 * IPM; it += F.NGW) { const int mtx = it / IPM, r = it % IPM;
            transpose_item(F.ap->in[25] + (size_t)mtx * D * D, D, D, (bf16_t*)(ws + WS_WOUT + (size_t)mtx * D * D), 2, scr, r, F.lane); }
    }
    {
        constexpr int IPM = (D / 64) * (QKV_N / 32);
        for (int it = F.gw; it < 2 * IPM; it += F.NGW) { const int mtx = it / IPM, r = it % IPM;
            transpose_item(F.ap->in[26] + (size_t)mtx * D * QKV_N, D, QKV_N, (bf16_t*)(ws + WS_WQKV + (size_t)mtx * QKV_N * D), 2, scr, r, F.lane); }
    }
    {
        constexpr int IPM = (D / 64) * (D / 32);
        for (int it = F.gw; it < 2 * IPM; it += F.NGW) { const int mtx = it / IPM, r = it % IPM;
            transpose_item(F.ap->in[28] + (size_t)mtx * D * D, D, D, (bf16_t*)(ws + WS_WO + (size_t)mtx * D * D), 2, scr, r, F.lane); }
    }
    const int gt = F.vcu * NTHR + F.tid, NGT = F.G * NTHR;
    for (int i = gt; i < 2 * LORA_N * LORA_K; i += NGT) {
        const int j = i / (LORA_N * LORA_K), r = i % (LORA_N * LORA_K), n = r / LORA_K, k = r % LORA_K; float v = 0.f;
        if (n < 1024) { if (k < 64) v = F.ap->in[12][(((size_t)j * 2 + (n >> 9)) * 64 + k) * 512 + (n & 511)]; }
        else if (n < 2048) { if (k >= 64 && k < 128) v = F.ap->in[14][(((size_t)j * 2 + ((n - 1024) >> 9)) * 64 + (k - 64)) * 512 + (n & 511)]; }
        else { if (k >= 128) v = F.ap->in[20][((size_t)j * 128 + (k - 128)) * 512 + (n - 2048)]; }
        ((bf16_t*)(ws + WS_WLORA))[i] = (bf16_t)f2bf(v);
    }
    for (int i = gt; i < 4 * 32 * D; i += NGT) { const int l = i / (32 * D), r = i % (32 * D), e = r / D, d = r % D;
        ((float*)(ws + WS_RWT))[i] = F.ap->in[30][((size_t)l * D + d) * 32 + e]; }
    for (int i = gt; i < 128 * 2048; i += NGT) { const int mtx = i >> 11, n = i & 2047; ((float*)(ws + WS_B1P))[(size_t)mtx * 2048 + w1_row(n)] = F.ap->in[33][i]; }
    __syncthreads();
    LAS float* ca = (LAS float*)F.lds;
    LAS float* red = (LAS float*)(F.lds + 32768);
    for (int i = F.tid; i < NB * D; i += NTHR) { const float c = F.ap->in[1][i]; ca[i] = c / (1.f + __expf(-c)); }
    __syncthreads();
    for (int u = F.vcu; u < 4 * 96; u += F.G) {
        const int l = u / 96, nb = u % 96, kq = F.wave, n = nb * 64 + F.lane;
        float acc[8];
#pragma unroll
        for (int b = 0; b < 8; ++b) acc[b] = 0.f;
        const float* wp = F.ap->in[2] + ((size_t)l * D + kq * 128) * 6144 + n;
#pragma unroll 4
        for (int k = 0; k < 128; ++k) { const float wv = wp[(size_t)k * 6144];
#pragma unroll
            for (int b = 0; b < 8; ++b) acc[b] += ca[b * D + kq * 128 + k] * wv; }
#pragma unroll
        for (int b = 0; b < 8; ++b) red[(kq * 8 + b) * 64 + F.lane] = acc[b];
        __syncthreads();
        { const int b = F.wave; float s = F.ap->in[3][(size_t)l * 6144 + n];
#pragma unroll
          for (int q = 0; q < 8; ++q) s += red[(q * 8 + b) * 64 + F.lane];
          ((float*)(ws + WS_MOD))[((size_t)l * NB + b) * 6144 + n] = s; }
        __syncthreads();
    }
}

DI float rms_rstd(const f32x4 (&v)[4]) {
    float s = 0.f;
#pragma unroll
    for (int j = 0; j < 4; ++j) s += (v[j].x * v[j].x + v[j].y * v[j].y) + (v[j].z * v[j].z + v[j].w * v[j].w);
    return __builtin_amdgcn_rsqf(wave_sum(s) * (1.f / D) + kf(1e-6f));
}
DI int rcol(int lane, int j) { return 8 * lane + 512 * (j >> 1) + 4 * (j & 1); }
DI void load_bf16_row(const bf16_t* row, int lane, f32x4 (&v)[4]) {
#pragma unroll
    for (int g = 0; g < 2; ++g) { const u32x4 w = *(const u32x4*)(row + 8 * lane + 512 * g);
        v[2 * g] = (f32x4){bf2f(w.x & 0xffffu), bf2f(w.x >> 16), bf2f(w.y & 0xffffu), bf2f(w.y >> 16)}; v[2 * g + 1] = (f32x4){bf2f(w.z & 0xffffu), bf2f(w.z >> 16), bf2f(w.w & 0xffffu), bf2f(w.w >> 16)}; }
}

DI void load_vec(const float* p, int lane, f32x4 (&v)[4]) {
#pragma unroll
    for (int j = 0; j < 4; ++j) v[j] = *(const f32x4*)(p + rcol(lane, j));
}
DI void mod_norm_row8(const f32x4 (&x)[4], const f32x4 (&A)[4], const f32x4 (&S)[4], unsigned char* orow, int lane) {
    const float rstd = rms_rstd(x);
#pragma unroll
    for (int g = 0; g < 2; ++g) { const f32x4 h0 = x[2 * g] * rstd * A[2 * g] + S[2 * g], h1 = x[2 * g + 1] * rstd * A[2 * g + 1] + S[2 * g + 1];
        u32x2 w; w.x = pk_fp8x4(h0.x, h0.y, h0.z, h0.w); w.y = pk_fp8x4(h1.x, h1.y, h1.z, h1.w); *(u32x2*)(orow + 8 * lane + 512 * g) = w; }
}
DI void store_bf16_row(bf16_t* row, int lane, const f32x4 (&v)[4]) {
#pragma unroll
    for (int g = 0; g < 2; ++g) { u32x4 w; w.x = pk2(v[2 * g].x, v[2 * g].y); w.y = pk2(v[2 * g].z, v[2 * g].w); w.z = pk2(v[2 * g + 1].x, v[2 * g + 1].y); w.w = pk2(v[2 * g + 1].z, v[2 * g + 1].w);
        *(u32x4*)(row + 8 * lane + 512 * g) = w; }
}
DI void phase_t0(const Frame& F) {
    const float* MOD = (const float*)(F.ws + WS_MOD);
    for (int blk = F.gw; blk < T / 16; blk += F.NGW) {
        const int t0 = blk * 16, b = t0 / SEQ; const float* m = MOD + ((size_t)0 * NB + b) * 6144;
        f32x4 A[4], S[4], g[4], sc[4]; load_vec(F.ap->in[4], F.lane, g); load_vec(m + 1 * D, F.lane, sc); load_vec(m, F.lane, S);
#pragma unroll
        for (int j = 0; j < 4; ++j) A[j] = g[j] * (sc[j] + 1.f);
#pragma unroll 2
        for (int q = 0; q < 16; ++q) { const int t = t0 + q; f32x4 x[4], hv[4];
            load_vec(F.ap->in[0] + (size_t)t * D, F.lane, x);
            store_bf16_row((bf16_t*)(F.ws + WS_XB) + (size_t)t * D, F.lane, x);
            mod_norm_row8(x, A, S, (unsigned char*)(F.ws + WS_H8) + (size_t)t * D, F.lane); }
    }
}

constexpr int HT_STRIDE = 1032, TL_PZ = 66560;
DI void phase_tail(const Frame& F, int l) {
    const float* MOD = (const float*)(F.ws + WS_MOD);
    LAS bf16_t* Ht = (LAS bf16_t*)F.lds;
    LAS float* Pz = (LAS float*)(F.lds + TL_PZ);
    LAS unsigned* hist = (LAS unsigned*)(F.lds + L_HIST);
    LAS unsigned* basew = (LAS unsigned*)(F.lds + L_BASE);
    const int r = F.lane & 31, h = F.lane >> 5;
    bf16x8 RWf[8];
    { const float* rw = (const float*)(F.ws + WS_RWT) + ((size_t)l * 32 + r) * D + 128 * F.wave + 8 * h;
#pragma unroll
      for (int s = 0; s < 8; ++s) { const f32x4 a = *(const f32x4*)(rw + 16 * s), b = *(const f32x4*)(rw + 16 * s + 4);
          u32x4 p; p.x = pk2(a.x, a.y); p.y = pk2(a.z, a.w); p.z = pk2(b.x, b.y); p.w = pk2(b.z, b.w); RWf[s] = __builtin_bit_cast(bf16x8, p); } }
    if (F.tid < 32) hist[F.tid] = 0u;
    __syncthreads();
    int* tok_e = (int*)(F.ws + WS_TOKE); int* tok_p = (int*)(F.ws + WS_TOKP); float* tok_g = (float*)(F.ws + WS_TOKG);
    const float rb = F.ap->in[31][l * 32 + r]; const float neg_big = kf(-3.0e38f);
    for (int ti = F.vcu; ti < T / 32; ti += F.G) {
        f32x4 Bv[4], Av[4], Sv[4];
        { const int b = (32 * ti) / SEQ; const float* m = MOD + ((size_t)l * NB + b) * 6144; f32x4 g[4], c[4];
          load_vec(F.ap->in[5] + (size_t)l * D, F.lane, g); load_vec(m + 2 * D, F.lane, c);
#pragma unroll
          for (int j = 0; j < 4; ++j) Bv[j] = g[j] * c[j];
          load_vec(F.ap->in[6] + (size_t)l * D, F.lane, g); load_vec(m + 4 * D, F.lane, c); load_vec(m + 3 * D, F.lane, Sv);
#pragma unroll
          for (int j = 0; j < 4; ++j) Av[j] = g[j] * (c[j] + 1.f); }
#pragma unroll 2
        for (int q = 0; q < 4; ++q) {
            const int tkl = 4 * F.wave + q, t = 32 * ti + tkl;
            f32x4 y[4], x[4], hv[4];
            load_bf16_row((const bf16_t*)(F.ws + WS_Y) + (size_t)t * D, F.lane, y);
            load_bf16_row((const bf16_t*)(F.ws + WS_XB) + (size_t)t * D, F.lane, x);
            const float rstd = rms_rstd(y);
#pragma unroll
            for (int j = 0; j < 4; ++j) x[j] = x[j] + Bv[j] * (y[j] * rstd);
            store_bf16_row((bf16_t*)(F.ws + WS_XB) + (size_t)t * D, F.lane, x);
            { const float rs2 = rms_rstd(x);
#pragma unroll
              for (int j = 0; j < 4; ++j) hv[j] = x[j] * rs2 * Av[j] + Sv[j];
#pragma unroll
              for (int g = 0; g < 2; ++g) { u32x2 w; w.x = pk_fp8x4(hv[2 * g].x, hv[2 * g].y, hv[2 * g].z, hv[2 * g].w); w.y = pk_fp8x4(hv[2 * g + 1].x, hv[2 * g + 1].y, hv[2 * g + 1].z, hv[2 * g + 1].w);
                  *(u32x2*)((unsigned char*)(F.ws + WS_H8) + (size_t)t * D + 8 * F.lane + 512 * g) = w; } }
#pragma unroll
            for (int g = 0; g < 2; ++g) { u32x4 w; w.x = pk2(hv[2 * g].x, hv[2 * g].y); w.y = pk2(hv[2 * g].z, hv[2 * g].w); w.z = pk2(hv[2 * g + 1].x, hv[2 * g + 1].y); w.w = pk2(hv[2 * g + 1].z, hv[2 * g + 1].w);
                *(LAS u32x4*)(Ht + tkl * HT_STRIDE + 8 * F.lane + 512 * g) = w; }
        }
        __syncthreads();
        { f32x16 acc;
#pragma unroll
          for (int i = 0; i < 16; ++i) acc[i] = 0.f;
#pragma unroll
          for (int s = 0; s < 8; ++s) { const bf16x8 af = *(const LAS bf16x8*)(Ht + r * HT_STRIDE + 128 * F.wave + 16 * s + 8 * h);
              acc = __builtin_amdgcn_mfma_f32_32x32x16_bf16(af, RWf[s], acc, 0, 0, 0); }
#pragma unroll
          for (int i = 0; i < 16; ++i) Pz[(F.wave * 32 + ((i & 3) + 8 * (i >> 2) + 4 * h)) * 32 + r] = acc[i]; }
        __syncthreads();
#pragma unroll 1
        for (int it = 0; it < 2; ++it) {
            const int tkl = 4 * F.wave + 2 * it + h, t = 32 * ti + tkl;
            float mylogit = rb;
#pragma unroll
            for (int w = 0; w < 8; ++w) mylogit += Pz[(w * 32 + tkl) * 32 + r];
            float tv[4]; int tix[4];
#pragma unroll
            for (int k = 0; k < 4; ++k) { float v = mylogit; int idx = r;
#pragma unroll
                for (int st = 0; st < 5; ++st) { float ov; int oi;
                    if (st == 0) { ov = __builtin_bit_cast(float, __builtin_amdgcn_update_dpp(0, __builtin_bit_cast(int, v), 0xB1, 0xf, 0xf, true)); oi = __builtin_amdgcn_update_dpp(0, idx, 0xB1, 0xf, 0xf, true); }
                    else if (st == 1) { ov = __builtin_bit_cast(float, __builtin_amdgcn_update_dpp(0, __builtin_bit_cast(int, v), 0x4E, 0xf, 0xf, true)); oi = __builtin_amdgcn_update_dpp(0, idx, 0x4E, 0xf, 0xf, true); }
                    else if (st == 2) { ov = __builtin_bit_cast(float, __builtin_amdgcn_update_dpp(0, __builtin_bit_cast(int, v), 0x141, 0xf, 0xf, true)); oi = __builtin_amdgcn_update_dpp(0, idx, 0x141, 0xf, 0xf, true); }
                    else if (st == 3) { ov = __builtin_bit_cast(float, __builtin_amdgcn_update_dpp(0, __builtin_bit_cast(int, v), 0x140, 0xf, 0xf, true)); oi = __builtin_amdgcn_update_dpp(0, idx, 0x140, 0xf, 0xf, true); }
                    else { ov = __builtin_bit_cast(float, shfl_src(__builtin_bit_cast(int, v), F.lane ^ 16)); oi = shfl_src(idx, F.lane ^ 16); }
                    if (ov > v || (ov == v && oi < idx)) { v = ov; idx = oi; } }
                tv[k] = v; tix[k] = idx; if (r == idx) mylogit = neg_big; }
            const float e1 = __expf(tv[1] - tv[0]), e2 = __expf(tv[2] - tv[0]), e3 = __expf(tv[3] - tv[0]); const float inv = __builtin_amdgcn_rcpf(1.f + e1 + e2 + e3);
            if (r < 4) { const int e = r == 0 ? tix[0] : r == 1 ? tix[1] : r == 2 ? tix[2] : tix[3];
                const float gk = (r == 0 ? 1.f : r == 1 ? e1 : r == 2 ? e2 : e3) * inv;
                const unsigned lp = atomicAdd((unsigned*)(hist + e), 1u);
                tok_e[(size_t)t * 4 + r] = e; tok_p[(size_t)t * 4 + r] = (int)lp; tok_g[(size_t)t * 4 + r] = gk; }
        }
    }
    __syncthreads();
    if (F.tid < 32) basew[F.tid] = __hip_atomic_fetch_add((unsigned*)(F.ws + WS_CTL) + CW_GCNT + l * 32 + F.tid, hist[F.tid], __ATOMIC_RELAXED, __HIP_MEMORY_SCOPE_AGENT);
    __syncthreads();
    for (int ti0 = F.vcu; ti0 < T / 32; ti0 += 4 * F.G) { const int ti = ti0 + (F.tid >> 7) * F.G;
        if (ti < T / 32) { const size_t i = (size_t)ti * 128 + (F.tid & 127); const int e = tok_e[i]; const int pos = tok_p[i] + (int)basew[e]; tok_p[i] = pos;
            ((int*)(F.ws + WS_SLOTTOK))[(size_t)e * pg8::CAPX + pos] = (int)(i >> 2); } }
}

DI void moe_tables(const Frame& F, int l) {
    LAS int* pstart = (LAS int*)(F.lds + L_PSTART); LAS int* ntl = (LAS int*)(F.lds + L_NTILES); LAS int* tile_e = (LAS int*)(F.lds + L_TILEE);
    __syncthreads();
    if (F.tid < 64) { const unsigned* gc = (const unsigned*)(F.ws + WS_CTL) + CW_GCNT + l * 32; const int e = F.lane;
        const int c = e < 32 ? (int)__hip_atomic_load(gc + e, __ATOMIC_RELAXED, __HIP_MEMORY_SCOPE_AGENT) : 0; const int tl = (c + 255) >> 8;
        int incl = tl;
#pragma unroll
        for (int o = 1; o < 32; o <<= 1) { const int v = shfl_src(incl, F.lane >= o ? F.lane - o : F.lane); if (F.lane >= o) incl += v; }
        const int st = incl - tl;
        if (e < 32) { pstart[e] = st * 256; ((LAS int*)(F.lds + L_CNT))[e] = c; }
        if (e == 31) { pstart[32] = incl * 256; ntl[0] = incl < MAX_TILES ? incl : MAX_TILES; }
#pragma clang loop unroll(disable) vectorize(disable)
        for (int i = 0; i < tl; ++i) if (st + i < MAX_TILES) tile_e[st + i] = e;
    }
    __syncthreads();
}


DI void phase_combine(const Frame& F, int l) {
    moe_tables(F, l);
    const LAS int* pstart = (const LAS int*)(F.lds + L_PSTART);
    const float* MOD = (const float*)(F.ws + WS_MOD);
    const int* tok_e = (const int*)(F.ws + WS_TOKE); const int* tok_p = (const int*)(F.ws + WS_TOKP); const float* tok_g = (const float*)(F.ws + WS_TOKG);
    const bool more = l + 1 < DEPTH; const float ysc = kf(1.f / 16.f);
    for (int blk = F.gw; blk < T / 16; blk += F.NGW) {
        const int t0 = blk * 16, b = t0 / SEQ; const float* m = MOD + ((size_t)l * NB + b) * 6144;
        f32x4 Bv[4], Av[4], Sv[4];
        { f32x4 g[4], c[4]; load_vec(F.ap->in[7] + (size_t)l * D, F.lane, g); load_vec(m + 5 * D, F.lane, c);
#pragma unroll
          for (int j = 0; j < 4; ++j) { Bv[j] = g[j] * c[j]; Av[j] = Bv[j]; Sv[j] = Bv[j]; }
          if (more) { const float* m2 = MOD + ((size_t)(l + 1) * NB + b) * 6144; load_vec(F.ap->in[4] + (size_t)(l + 1) * D, F.lane, g); load_vec(m2 + 1 * D, F.lane, c); load_vec(m2, F.lane, Sv);
#pragma unroll
              for (int j = 0; j < 4; ++j) Av[j] = g[j] * (c[j] + 1.f); } }
        const int ev = tok_e[(size_t)t0 * 4 + F.lane]; const int slotv = pstart[ev] + tok_p[(size_t)t0 * 4 + F.lane]; const int gvi = __builtin_bit_cast(int, tok_g[(size_t)t0 * 4 + F.lane]);
#pragma unroll 2
        for (int q = 0; q < 16; ++q) { const int t = t0 + q;
            f32x4 y[4], x[4], hv[4];
#pragma unroll
            for (int j = 0; j < 4; ++j) y[j] = (f32x4){0.f, 0.f, 0.f, 0.f};
            load_bf16_row((const bf16_t*)(F.ws + WS_XB) + (size_t)t * D, F.lane, x);
#pragma unroll
            for (int k = 0; k < 4; ++k) { const int slot = __builtin_amdgcn_readlane(slotv, 4 * q + k); const float gk = __builtin_bit_cast(float, __builtin_amdgcn_readlane(gvi, 4 * q + k)) * ysc;
                const unsigned char* rp = (const unsigned char*)(F.ws + WS_XS) + (size_t)slot * D + 8 * F.lane; unsigned w[4];
#pragma unroll
                for (int g = 0; g < 2; ++g) { const u32x2 ww = *(const u32x2*)(rp + 512 * g); w[2 * g] = ww.x; w[2 * g + 1] = ww.y; }
#pragma unroll
                for (int j = 0; j < 4; ++j) { const f32x2 lo = __builtin_amdgcn_cvt_pk_f32_fp8((int)w[j], false), hi = __builtin_amdgcn_cvt_pk_f32_fp8((int)w[j], true); y[j] += (f32x4){lo.x, lo.y, hi.x, hi.y} * gk; } }
            const float rstd = rms_rstd(y);
#pragma unroll
            for (int j = 0; j < 4; ++j) x[j] = x[j] + Bv[j] * (y[j] * rstd);
            if (more) { store_bf16_row((bf16_t*)(F.ws + WS_XB) + (size_t)t * D, F.lane, x); mod_norm_row8(x, Av, Sv, (unsigned char*)(F.ws + WS_H8) + (size_t)t * D, F.lane); }
            else {
#pragma unroll
                for (int j = 0; j < 4; ++j) *(f32x4*)(F.ap->out + (size_t)t * D + rcol(F.lane, j)) = x[j]; }
        }
    }
}

DI void unpack8(const u32x4 w, float (&o)[8]) { o[0] = bf2f(w.x & 0xffffu); o[1] = bf2f(w.x >> 16); o[2] = bf2f(w.y & 0xffffu); o[3] = bf2f(w.y >> 16); o[4] = bf2f(w.z & 0xffffu); o[5] = bf2f(w.z >> 16); o[6] = bf2f(w.w & 0xffffu); o[7] = bf2f(w.w >> 16); }
DI void load8f(const float* p, float (&o)[8]) { const f32x4 a = *(const f32x4*)p, b = *(const f32x4*)(p + 4); o[0] = a.x; o[1] = a.y; o[2] = a.z; o[3] = a.w; o[4] = b.x; o[5] = b.y; o[6] = b.z; o[7] = b.w; }
DI void store8f(float* p, const float (&o)[8]) { *(f32x4*)p = (f32x4){o[0], o[1], o[2], o[3]}; *(f32x4*)(p + 4) = (f32x4){o[4], o[5], o[6], o[7]}; }
DI void phase_e3a(const Frame& F, int j) {
    const bf16_t* P = (const bf16_t*)(F.ws + WS_P);
    const float* mup = F.ap->in[9] + (size_t)j * A_PROJ; const float* mun = F.ap->in[10] + (size_t)j * A_PROJ;
    const f32x4 mp = *(const f32x4*)(mup + 1536 + 4 * F.lane), mn = *(const f32x4*)(mun + 1536 + 4 * F.lane);
#pragma unroll 2
    for (int t = F.gw; t < T; t += F.NGW) {
        const int tt = t & (SEQ - 1); const int col = 1536 + 4 * F.lane;
        const u32x2 pc = *(const u32x2*)(P + (size_t)t * AB_PROJ + col);
        u32x2 pp = (u32x2){0u, 0u}, pn = (u32x2){0u, 0u};
        if (tt > 0) pp = *(const u32x2*)(P + (size_t)(t - 1) * AB_PROJ + col);
        if (tt < SEQ - 1) pn = *(const u32x2*)(P + (size_t)(t + 1) * AB_PROJ + col);
        const f32x4 c = (f32x4){bf2f(pc.x & 0xffffu), bf2f(pc.x >> 16), bf2f(pc.y & 0xffffu), bf2f(pc.y >> 16)};
        const f32x4 pv = (f32x4){bf2f(pp.x & 0xffffu), bf2f(pp.x >> 16), bf2f(pp.y & 0xffffu), bf2f(pp.y >> 16)};
        const f32x4 nv = (f32x4){bf2f(pn.x & 0xffffu), bf2f(pn.x >> 16), bf2f(pn.y & 0xffffu), bf2f(pn.y >> 16)};
        f32x4 s = c + mp * (pv - c) + mn * (nv - c);
        if (F.lane < 16) { s.x = tanhf_(s.x); s.y = tanhf_(s.y); s.z = tanhf_(s.z); s.w = tanhf_(s.w); }
        else if (F.lane >= 32) { s.x = sigmoidf_(s.x); s.y = sigmoidf_(s.y); s.z = sigmoidf_(s.z); s.w = sigmoidf_(s.w); }
        u32x2 w; w.x = pk2(s.x, s.y); w.y = pk2(s.z, s.w);
        *(u32x2*)((bf16_t*)(F.ws + WS_LIN) + (size_t)t * LORA_K + 4 * F.lane) = w;
    }
    LAS float* hc = (LAS float*)F.lds;
    const float* cw = F.ap->in[21] + (size_t)j * 31 * 512; const float* cb = F.ap->in[22] + (size_t)j * 512;
    const float* gg = F.ap->in[23] + (size_t)j * 512; const float* gb = F.ap->in[24] + (size_t)j * 512;
    unsigned char* YAB = (unsigned char*)(F.ws + WS_YAB); const float eps5 = kf(1e-5f);
    for (int u = F.vcu; u < NB * 32 * 8; u += F.G) {
        const int g = u & 7, tile = (u >> 3) & 31, b = u >> 8; const int t0 = tile * 128, ch = g * 64 + F.lane;
        __syncthreads();
        {
            u32x4 uu[3], gv[3]; bool ok[3];
#pragma unroll
            for (int it = 0; it < 3; ++it) { const int cidx = F.tid + it * NTHR, r = cidx >> 3, part = cidx & 7, tt = t0 - 15 + r; ok[it] = cidx < 158 * 8 && tt >= 0 && tt < SEQ;
                uu[it] = (u32x4){0u, 0u, 0u, 0u}; gv[it] = (u32x4){0u, 0u, 0u, 0u};
                if (ok[it]) { const bf16_t* pr = P + (size_t)(b * SEQ + tt) * AB_PROJ + A_PROJ + g * 64 + part * 8; uu[it] = *(const u32x4*)pr; gv[it] = *(const u32x4*)(pr + 512); } }
#pragma unroll
            for (int it = 0; it < 3; ++it) { const int cidx = F.tid + it * NTHR;
                if (cidx < 158 * 8) { float a[8], gt[8], o[8]; unpack8(uu[it], a); unpack8(gv[it], gt);
#pragma unroll
                    for (int i = 0; i < 8; ++i) o[i] = ok[it] ? a[i] * sigmoidf_(gt[i]) : 0.f;
                    LAS f32x4* dst = (LAS f32x4*)(hc + cidx * 8); dst[0] = (f32x4){o[0], o[1], o[2], o[3]}; dst[1] = (f32x4){o[4], o[5], o[6], o[7]}; } }
        }
        __syncthreads();
        float w[31];
#pragma unroll
        for (int q = 0; q < 31; ++q) w[q] = cw[q * 512 + ch];
        const float bias = cb[ch], gng = gg[ch], gnb = gb[ch];
        float x[46];
#pragma unroll
        for (int q = 0; q < 46; ++q) x[q] = hc[(F.wave * 16 + q) * 64 + F.lane];
#pragma unroll
        for (int i = 0; i < 16; ++i) { float acc = bias;
#pragma unroll
            for (int q = 0; q < 31; ++q) acc += x[i + q] * w[q];
            const float mean = wave_sum(acc) * (1.f / 64.f); const float dlt = acc - mean; const float var = wave_sum(dlt * dlt) * (1.f / 64.f);
            const float yv = dlt * __builtin_amdgcn_rsqf(var + eps5) * gng + gnb; const float o = yv * sigmoidf_(yv);
            YAB[(size_t)(b * SEQ + t0 + F.wave * 16 + i) * D + 512 + ch] = (unsigned char)(pk_fp8x4(o, 0.f, 0.f, 0.f) & 0xffu); }
    }
}

DI float red8(float x) {
    x += __builtin_bit_cast(float, __builtin_amdgcn_update_dpp(0, __builtin_bit_cast(int, x), 0xB1, 0xf, 0xf, true));
    x += __builtin_bit_cast(float, __builtin_amdgcn_update_dpp(0, __builtin_bit_cast(int, x), 0x4E, 0xf, 0xf, true));
    x = DPP_ADD(x, 0x141);
    return x;
}
DI float quad_sum(float x) {
    x += __builtin_bit_cast(float, __builtin_amdgcn_update_dpp(0, __builtin_bit_cast(int, x), 0xB1, 0xf, 0xf, true));
    x += __builtin_bit_cast(float, __builtin_amdgcn_update_dpp(0, __builtin_bit_cast(int, x), 0x4E, 0xf, 0xf, true));
    return x;
}

typedef __bf16 bfv2 __attribute__((ext_vector_type(2)));
DI unsigned cvt2(float lo, float hi) { return __builtin_bit_cast(unsigned, __builtin_convertvector((f32x2){lo, hi}, bfv2)); }
constexpr int NSUB = 256;
constexpr size_t C_TH = 2976 * MiB, C_KH = 3232 * MiB, C_RH = 3296 * MiB, C_WH = 3360 * MiB, C_VT = 3376 * MiB, C_Y = 3440 * MiB;
constexpr int G_STR = 72;
constexpr int SL_G1 = 0, SL_C1T = 0, SL_MS = 2560, SL_NK = 3072, SL_WBT = 3584, SL_G2 = 4608, SL_NB = 4608, SL_WKT = 5632, SL_G2R = 4608 + 16 * G_STR * 2, SL_AT = 9216, SL_BT = 11264, SL_KT = 13312, SL_PL = 15360;
DI void sub_tail(const Frame& F, LAS unsigned char* wl, const size_t u, const float (&at)[16], const float (&bt)[16], const float (&kt)[16], const float (&rt)[16], const float (&vt)[16], const float p) {
    bf16_t* THT = (bf16_t*)(F.ws + C_TH); bf16_t* KHA = (bf16_t*)(F.ws + C_KH); bf16_t* RHT = (bf16_t*)(F.ws + C_RH); bf16_t* WHT = (bf16_t*)(F.ws + C_WH); bf16_t* VTG = (bf16_t*)(F.ws + C_VT);
    int ln = F.lane; asm volatile("" : "+v"(ln));
    const int k = ln, r = ln & 31, h = ln >> 5, c16 = ln & 15, q4 = ln >> 4;
        { LAS bf16_t* G1 = (LAS bf16_t*)(wl + SL_G1); LAS bf16_t* G2 = (LAS bf16_t*)(wl + SL_G2);
#pragma unroll
          for (int t = 0; t < 16; ++t) { const unsigned c0 = cvt2(bt[t], kt[t]), c1 = cvt2(at[t], rt[t]); G1[t * G_STR + k] = (bf16_t)(c0 & 0xffffu); G1[(16 + t) * G_STR + k] = (bf16_t)(c0 >> 16); G2[t * G_STR + k] = (bf16_t)(c1 & 0xffffu); G2[(16 + t) * G_STR + k] = (bf16_t)(c1 >> 16); }
          u32x4 w0, w1;
          w0 = (u32x4){cvt2(at[0], at[1]), cvt2(at[2], at[3]), cvt2(at[4], at[5]), cvt2(at[6], at[7])}; w1 = (u32x4){cvt2(at[8], at[9]), cvt2(at[10], at[11]), cvt2(at[12], at[13]), cvt2(at[14], at[15])};
          *(LAS u32x4*)(wl + SL_AT + k * 32) = w0; *(LAS u32x4*)(wl + SL_AT + k * 32 + 16) = w1;
          w0 = (u32x4){cvt2(bt[0], bt[1]), cvt2(bt[2], bt[3]), cvt2(bt[4], bt[5]), cvt2(bt[6], bt[7])}; w1 = (u32x4){cvt2(bt[8], bt[9]), cvt2(bt[10], bt[11]), cvt2(bt[12], bt[13]), cvt2(bt[14], bt[15])};
          *(LAS u32x4*)(wl + SL_BT + k * 32) = w0; *(LAS u32x4*)(wl + SL_BT + k * 32 + 16) = w1;
          w0 = (u32x4){cvt2(kt[0], kt[1]), cvt2(kt[2], kt[3]), cvt2(kt[4], kt[5]), cvt2(kt[6], kt[7])}; w1 = (u32x4){cvt2(kt[8], kt[9]), cvt2(kt[10], kt[11]), cvt2(kt[12], kt[13]), cvt2(kt[14], kt[15])};
          *(LAS u32x4*)(wl + SL_KT + k * 32) = w0; *(LAS u32x4*)(wl + SL_KT + k * 32 + 16) = w1;
          w0 = (u32x4){cvt2(vt[0], vt[1]), cvt2(vt[2], vt[3]), cvt2(vt[4], vt[5]), cvt2(vt[6], vt[7])}; w1 = (u32x4){cvt2(vt[8], vt[9]), cvt2(vt[10], vt[11]), cvt2(vt[12], vt[13]), cvt2(vt[14], vt[15])};
          u32x4* vg = (u32x4*)(VTG + (size_t)u * 1024 + k * 16); vg[0] = w0; vg[1] = w1;
          *(LAS float*)(wl + SL_PL + k * 4) = p; }
        f32x16 x;
#pragma unroll
        for (int i = 0; i < 16; ++i) x[i] = 0.f;
#pragma unroll
        for (int s = 0; s < 4; ++s) { const bf16x8 af = *(const LAS bf16x8*)(wl + SL_G1 + (r * G_STR + 16 * s + 8 * h) * 2), bf = *(const LAS bf16x8*)(wl + SL_G2 + (r * G_STR + 16 * s + 8 * h) * 2);
            x = __builtin_amdgcn_mfma_f32_32x32x16_bf16(af, bf, x, 0, 0, 0); }
        {
            float xv[16];
#pragma unroll
            for (int i = 0; i < 16; ++i) xv[i] = x[i];
            asm volatile("" ::: "memory");
#pragma unroll
            for (int i = 0; i < 8; ++i) { const int m = (i & 3) + 8 * (i >> 2) + 4 * h;
                if (r < 16) *(LAS float*)(wl + SL_NB + (m * 16 + r) * 4) = (m < r) ? xv[i] : 0.f;
                else *(LAS bf16_t*)(wl + SL_WBT + ((r - 16) * 16 + m) * 2) = (bf16_t)f2bf((m <= r - 16) ? xv[i] : 0.f); }
#pragma unroll
            for (int i = 8; i < 16; ++i) { const int m = (i & 3) + 8 * ((i >> 2) - 2) + 4 * h;
                if (r < 16) *(LAS bf16_t*)(wl + SL_NK + (m * 16 + r) * 2) = (bf16_t)f2bf((m < r) ? xv[i] : 0.f);
                else *(LAS float*)(wl + SL_WKT + ((r - 16) * 16 + m) * 4) = (m <= r - 16) ? xv[i] : 0.f; }
        }
        {   float M[16];
#pragma unroll
            for (int s = 15; s >= 0; --s) { float acc = 0.f;
#pragma unroll
                for (int uu = s + 1; uu < 16; ++uu) acc += *(const LAS float*)(wl + SL_NB + (s * 16 + uu) * 4) * M[uu];
                M[s] = (s == c16) ? 1.f : ((s > c16) ? 0.f : acc); }
            if (ln < 16) {
#pragma unroll
                for (int s = 0; s < 16; ++s) *(LAS bf16_t*)(wl + SL_MS + (s * 16 + c16) * 2) = (bf16_t)f2bf(M[s]); }
        }
        {   const s16x4 a1 = *(const LAS s16x4*)(wl + SL_MS + (c16 * 16 + 4 * q4) * 2);
#pragma unroll
            for (int nt = 0; nt < 5; ++nt) { const s16x4 b1 = nt == 0 ? *(const LAS s16x4*)(wl + SL_WBT + (c16 * 16 + 4 * q4) * 2) : *(const LAS s16x4*)(wl + SL_BT + ((16 * (nt - 1) + c16) * 16 + 4 * q4) * 2);
                f32x4 c = (f32x4){0.f, 0.f, 0.f, 0.f}; c = __builtin_amdgcn_mfma_f32_16x16x16bf16_1k(a1, b1, c, 0, 0, 0);
                u32x2 w; w.x = cvt2(c[0], c[1]); w.y = cvt2(c[2], c[3]); *(LAS u32x2*)(wl + SL_C1T + ((16 * nt + c16) * 16 + 4 * q4) * 2) = w; }
        }
        {   s16x4 b2[5];
#pragma unroll
            for (int nt = 0; nt < 5; ++nt) b2[nt] = *(const LAS s16x4*)(wl + SL_C1T + ((16 * nt + c16) * 16 + 4 * q4) * 2);
            float pl[4];
#pragma unroll
            for (int nt = 1; nt < 5; ++nt) pl[nt - 1] = *(const LAS float*)(wl + SL_PL + (16 * (nt - 1) + c16) * 4);
#pragma unroll
            for (int mt = 0; mt < 5; ++mt) { const s16x4 a2 = mt < 4 ? *(const LAS s16x4*)(wl + SL_AT + ((16 * mt + c16) * 16 + 4 * q4) * 2) : *(const LAS s16x4*)(wl + SL_NK + (c16 * 16 + 4 * q4) * 2);
#pragma unroll
                for (int nt = 0; nt < 5; ++nt) { f32x4 c = (f32x4){0.f, 0.f, 0.f, 0.f}; c = __builtin_amdgcn_mfma_f32_16x16x16bf16_1k(a2, b2[nt], c, 0, 0, 0);
                    const int r0 = 4 * q4;
                    if (mt < 4 && nt == 0) { const u32x2 g = *(const LAS u32x2*)(wl + SL_G2R + (c16 * G_STR + 16 * mt + r0) * 2);
                        u32x2 w; w.x = cvt2(c[0] + bf2f(g.x & 0xffffu), c[1] + bf2f(g.x >> 16)); w.y = cvt2(c[2] + bf2f(g.y & 0xffffu), c[3] + bf2f(g.y >> 16));
                        *(u32x2*)(RHT + (size_t)u * 1024 + c16 * 64 + 4 * ((4 * mt + q4) ^ c16)) = w; }
                    else if (mt < 4) { const int kp = 16 * (nt - 1) + c16, k0 = 16 * mt + r0; const float s = pl[nt - 1];
                        u32x2 w; w.x = cvt2((c[0] + (k0 == kp ? 1.f : 0.f)) * s, (c[1] + (k0 + 1 == kp ? 1.f : 0.f)) * s); w.y = cvt2((c[2] + (k0 + 2 == kp ? 1.f : 0.f)) * s, (c[3] + (k0 + 3 == kp ? 1.f : 0.f)) * s);
                        *(u32x2*)(THT + (size_t)u * 4096 + kp * 64 + 4 * ((4 * mt + q4) ^ c16)) = w; }
                    else if (nt == 0) { const f32x4 wk = *(const LAS f32x4*)(wl + SL_WKT + (c16 * 16 + r0) * 4);
                        u32x2 w; w.x = cvt2(c[0] + wk[0], c[1] + wk[1]); w.y = cvt2(c[2] + wk[2], c[3] + wk[3]);
                        *(u32x2*)(WHT + (size_t)u * 256 + c16 * 16 + r0) = w; }
                    else { const int kp = 16 * (nt - 1) + c16; const float s = pl[nt - 1]; const u32x2 g = *(const LAS u32x2*)(wl + SL_KT + (kp * 16 + r0) * 2);
                        u32x2 w; w.x = cvt2((c[0] + bf2f(g.x & 0xffffu)) * s, (c[1] + bf2f(g.x >> 16)) * s); w.y = cvt2((c[2] + bf2f(g.y & 0xffffu)) * s, (c[3] + bf2f(g.y >> 16)) * s);
                        *(u32x2*)(KHA + (size_t)u * 1024 + kp * 16 + r0) = w; }
                }
            }
        }
    asm volatile("s_waitcnt lgkmcnt(0)" ::: "memory");
}
DI float softplus_(float x) { return fmaxf(x, 0.f) + __logf(1.f + __expf(-fabsf(x))); }
DI void phase_rsub(const Frame& F, int j) {
    const bf16_t* P = (const bf16_t*)(F.ws + WS_P); const bf16_t* LO = (const bf16_t*)(F.ws + WS_LO);
    float* BS = (float*)(F.ws + WS_BS);
    LAS unsigned char* wl = F.lds + F.wave * 16384;
    const int k = F.lane; const float dk = kf(-0.60653066f);
    for (int u = F.gw; u < NB * NSUB * RH; u += F.NGW) {
        const int hd = u & 7, jj = (u >> 3) & (NSUB - 1), b = u >> 11, ch = hd * 64 + k, tt0 = 16 * jj;
        float mp[3], mn[3];
#pragma unroll
        for (int q = 0; q < 3; ++q) { mp[q] = F.ap->in[9][(size_t)j * A_PROJ + q * 512 + ch]; mn[q] = F.ap->in[10][(size_t)j * A_PROJ + q * 512 + ch]; }
        const float kkw = F.ap->in[15][j * 512 + ch], kaw = F.ap->in[16][j * 512 + ch], rkw = F.ap->in[17][j * 512 + ch];
        const float w00 = F.ap->in[11][(j * 2 + 0) * 512 + ch], w01 = F.ap->in[11][(j * 2 + 1) * 512 + ch], a00 = F.ap->in[13][(j * 2 + 0) * 512 + ch], a01 = F.ap->in[13][(j * 2 + 1) * 512 + ch];
        unsigned RA[16], VL[16], KB0[16], LK1[16], B1[16]; float bsv = 0.f;
        {   float r0[3], r1[3];
#pragma unroll
            for (int q = 0; q < 3; ++q) { const bf16_t* pr = P + (size_t)(b * SEQ + tt0) * AB_PROJ + ch + q * 512; r0[q] = tt0 > 0 ? bf2f(pr[-AB_PROJ]) : 0.f; r1[q] = bf2f(pr[0]); }
#pragma unroll
            for (int g4 = 0; g4 < 4; ++g4) {
                float nx[4][3], lov[4][4];
#pragma unroll
                for (int ii = 0; ii < 4; ++ii) { const int tt = tt0 + 4 * g4 + ii + 1; const bool ok = tt < SEQ; const bf16_t* pr = P + (size_t)(b * SEQ + (ok ? tt : tt0)) * AB_PROJ + ch;
#pragma unroll
                    for (int q = 0; q < 3; ++q) { const float v = bf2f(pr[q * 512]); nx[ii][q] = ok ? v : 0.f; }
                    const bf16_t* lo = LO + ((size_t)b * SEQ + tt0 + 4 * g4 + ii) * LORA_N + ch;
#pragma unroll
                    for (int q = 0; q < 4; ++q) lov[ii][q] = bf2f(lo[q * 512]); }
#pragma unroll
                for (int ii = 0; ii < 4; ++ii) { const int i = 4 * g4 + ii; float x[3];
#pragma unroll
                    for (int q = 0; q < 3; ++q) { const float c = r1[q]; x[q] = c + mp[q] * (r0[q] - c) + mn[q] * (nx[ii][q] - c); r0[q] = c; r1[q] = nx[ii][q]; }
                    const float wl0 = lov[ii][0], wl1 = lov[ii][1], al0 = lov[ii][2], al1 = lov[ii][3];
                    const float kk = x[1] * kkw; const float kkn = kk * __builtin_amdgcn_rsqf(fmaxf(wave_sum(kk * kk), 1e-24f));
                    const float lw0 = dk * sigmoidf_(w00 + wl0), lw1 = dk * sigmoidf_(w01 + wl1);
                    const float ad0 = sigmoidf_(a00 + al0), ad1 = sigmoidf_(a01 + al1);
                    const float kd0 = x[1] * (1.f + (ad0 - 1.f) * kaw), kd1 = x[1] * (1.f + (ad1 - 1.f) * kaw);
                    const float bs = wave_sum(x[0] * (kd0 + kd1) * rkw);
                    bsv = k == i ? bs : bsv;
                    RA[i] = cvt2(x[0], -kkn); VL[i] = cvt2(x[2], lw0); KB0[i] = cvt2(kd0, kkn * ad0); LK1[i] = cvt2(lw1, kd1); B1[i] = cvt2(kkn * ad1, 0.f); }
                asm volatile("" ::: "memory");
            }
            if (k < 16) BS[((size_t)b * SEQ + tt0 + k) * 8 + hd] = bsv; }
        {
            float at[16], bt[16], kt[16], rt[16], vt[16]; float p = 1.f, cum = 0.f;
#pragma unroll
            for (int t = 0; t < 16; ++t) { const float rv = bf2f(RA[t] & 0xffffu), av = bf2f(RA[t] >> 16), vv = bf2f(VL[t] & 0xffffu), lw = bf2f(VL[t] >> 16), kv = bf2f(KB0[t] & 0xffffu), bv = bf2f(KB0[t] >> 16);
                at[t] = p * av; cum += lw; p = __expf(cum); const float ip = __expf(-cum); bt[t] = bv * ip; kt[t] = kv * ip; rt[t] = p * rv; vt[t] = vv; }
            sub_tail(F, wl, (size_t)((b * 16 + hd * 2 + 0) * NSUB + jj), at, bt, kt, rt, vt, p); }
        {
            float at[16], bt[16], kt[16], rt[16], vt[16]; float p = 1.f, cum = 0.f;
#pragma unroll
            for (int t = 0; t < 16; ++t) { const int i = 15 - t; const float rv = bf2f(RA[i] & 0xffffu), av = bf2f(RA[i] >> 16), vv = bf2f(VL[i] & 0xffffu), lw = bf2f(LK1[i] & 0xffffu), kv = bf2f(LK1[i] >> 16), bv = bf2f(B1[i] & 0xffffu);
                at[t] = p * av; cum += lw; p = __expf(cum); const float ip = __expf(-cum); bt[t] = bv * ip; kt[t] = kv * ip; rt[t] = p * rv; vt[t] = vv; }
            sub_tail(F, wl, (size_t)((b * 16 + hd * 2 + 1) * NSUB + (NSUB - 1 - jj)), at, bt, kt, rt, vt, p); }
    }
}

constexpr int CH_NST = 6, CH_PF = 4, CH_STB = 14336, CH_YB = CH_NST * CH_STB;
DI void chain_issue(LAS unsigned char* st, const bf16_t* THT, const bf16_t* KHA, const bf16_t* RHT, const bf16_t* WHT, const bf16_t* VTG, size_t u, int rb, int lane) {
    const char* th = (const char*)(THT + u * 4096) + lane * 16;
#pragma unroll
    for (int i = 0; i < 8; ++i) __builtin_amdgcn_global_load_lds((const unsigned*)(th + i * 1024), (LAS unsigned*)(st + i * 1024), 16, 0, 0);
    const char* kh = (const char*)(KHA + u * 1024) + lane * 16;
    __builtin_amdgcn_global_load_lds((const unsigned*)kh, (LAS unsigned*)(st + 8192), 16, 0, 0); __builtin_amdgcn_global_load_lds((const unsigned*)(kh + 1024), (LAS unsigned*)(st + 9216), 16, 0, 0);
    const char* rh = (const char*)(RHT + u * 1024) + lane * 16;
    __builtin_amdgcn_global_load_lds((const unsigned*)rh, (LAS unsigned*)(st + 10240), 16, 0, 0); __builtin_amdgcn_global_load_lds((const unsigned*)(rh + 1024), (LAS unsigned*)(st + 11264), 16, 0, 0);
    const char* vt = (const char*)(VTG + u * 1024 + rb * 512);
    const char* gx = lane < 32 ? (const char*)(WHT + u * 256) + lane * 16 : vt + (lane - 32) * 16;
    const char* gy = vt + 512 + (lane & 31) * 16;
    __builtin_amdgcn_global_load_lds((const unsigned*)gx, (LAS unsigned*)(st + 12288), 16, 0, 0); __builtin_amdgcn_global_load_lds((const unsigned*)gy, (LAS unsigned*)(st + 13312), 16, 0, 0);
}
DI bf16x8 pack8(const f32x16& x, int s) {
    u32x4 p; p.x = cvt2(x[8 * s], x[8 * s + 1]); p.y = cvt2(x[8 * s + 2], x[8 * s + 3]); p.z = cvt2(x[8 * s + 4], x[8 * s + 5]); p.w = cvt2(x[8 * s + 6], x[8 * s + 7]);
    return __builtin_bit_cast(bf16x8, p);
}
DI bf16x8 cat8(const LAS unsigned char* p0, const LAS unsigned char* p1) { const s16x4 a = *(const LAS s16x4*)p0, b = *(const LAS s16x4*)p1; return __builtin_shufflevector(a, b, 0, 1, 2, 3, 4, 5, 6, 7); }
DI void phase_chain(const Frame& F) {
    const bf16_t* THT = (const bf16_t*)(F.ws + C_TH); const bf16_t* KHA = (const bf16_t*)(F.ws + C_KH); const bf16_t* RHT = (const bf16_t*)(F.ws + C_RH); const bf16_t* WHT = (const bf16_t*)(F.ws + C_WH); const bf16_t* VTG = (const bf16_t*)(F.ws + C_VT);
    bf16_t* YD = (bf16_t*)(F.ws + C_Y);
    const int r = F.lane & 31, h = F.lane >> 5, rs = r & 15;
    LAS unsigned char* ring = F.lds; LAS unsigned char* ybuf = F.lds + CH_YB;
    for (int task = F.vcu; task < NSEQ * 2; task += F.G) {
        const int seq = task >> 1, rb = task & 1, b = seq >> 4, hd = (seq >> 1) & 7, d = seq & 1;
        const size_t u0 = (size_t)seq * NSUB;
        if (F.wave >= 2) {
#pragma unroll 1
            for (int jj = 0; jj <= NSUB; ++jj) __builtin_amdgcn_s_barrier();
        } else if (F.wave == 1) {
#pragma unroll 1
            for (int s = 0; s < CH_PF; ++s) chain_issue(ring + s * CH_STB, THT, KHA, RHT, WHT, VTG, u0 + s, rb, F.lane);
            int nst = CH_PF;
#pragma unroll 1
            for (int jj = 0; jj < NSUB; ++jj) {
                const int jn = jj + CH_PF < NSUB ? jj + CH_PF : NSUB - 1;
                chain_issue(ring + nst * CH_STB, THT, KHA, RHT, WHT, VTG, u0 + jn, rb, F.lane);
                nst = nst == CH_NST - 1 ? 0 : nst + 1;
                asm volatile("s_waitcnt vmcnt(56)" ::: "memory");
                __builtin_amdgcn_s_barrier();
            }
            VM_WAIT();
            __builtin_amdgcn_s_barrier();
        } else {
            f32x16 S0, S1;
#pragma unroll
            for (int i = 0; i < 16; ++i) { S0[i] = 0.f; S1[i] = 0.f; }
            int cur = 0;
#pragma unroll 1
            for (int jj = 0; jj < NSUB; ++jj) {
                __builtin_amdgcn_s_barrier(); asm volatile("" ::: "memory");
                const LAS unsigned char* st = ring + cur * CH_STB;
                bf16x8 sb[4]; sb[0] = pack8(S0, 0); sb[1] = pack8(S0, 1); sb[2] = pack8(S1, 0); sb[3] = pack8(S1, 1);
                const bf16x8 vt = *(const LAS bf16x8*)(st + 12800 + r * 32 + h * 16), wh = *(const LAS bf16x8*)(st + 12288 + rs * 32 + h * 16);
                const bf16x8 kh0 = *(const LAS bf16x8*)(st + 8192 + r * 32 + h * 16), kh1 = *(const LAS bf16x8*)(st + 8192 + (32 + r) * 32 + h * 16);
                f32x16 Y, N0, N1;
#pragma unroll
                for (int i = 0; i < 16; ++i) { Y[i] = 0.f; N0[i] = 0.f; N1[i] = 0.f; }
                Y = __builtin_amdgcn_mfma_f32_32x32x16_bf16(wh, vt, Y, 0, 0, 0);
                N0 = __builtin_amdgcn_mfma_f32_32x32x16_bf16(kh0, vt, N0, 0, 0, 0);
                N1 = __builtin_amdgcn_mfma_f32_32x32x16_bf16(kh1, vt, N1, 0, 0, 0);
#pragma unroll
                for (int ks = 0; ks < 4; ++ks) { const int c0 = ((4 * ks + h) ^ rs) * 8, c1 = ((4 * ks + h + 2) ^ rs) * 8;
                    Y = __builtin_amdgcn_mfma_f32_32x32x16_bf16(cat8(st + 10240 + rs * 128 + c0, st + 10240 + rs * 128 + c1), sb[ks], Y, 0, 0, 0);
                    N0 = __builtin_amdgcn_mfma_f32_32x32x16_bf16(cat8(st + r * 128 + c0, st + r * 128 + c1), sb[ks], N0, 0, 0, 0);
                    N1 = __builtin_amdgcn_mfma_f32_32x32x16_bf16(cat8(st + (32 + r) * 128 + c0, st + (32 + r) * 128 + c1), sb[ks], N1, 0, 0, 0); }
                S0 = N0; S1 = N1;
#pragma unroll
                for (int q = 0; q < 8; q += 1) { const int t = (q & 3) + 8 * (q >> 2) + 4 * h; *(LAS bf16_t*)(ybuf + (t * 32 + r) * 2) = (bf16_t)(cvt2(Y[q], 0.f) & 0xffffu); }
                { const u32x4 w = *(const LAS u32x4*)(ybuf + F.lane * 16); const int t = F.lane >> 2, step = 16 * jj + t, tt = d ? (SEQ - 1 - step) : step;
                  *(u32x4*)(YD + ((size_t)d * T + (size_t)b * SEQ + tt) * 512 + hd * 64 + 32 * rb + 8 * (F.lane & 3)) = w; }
                cur = cur == CH_NST - 1 ? 0 : cur + 1;
            }
            VM_WAIT();
            asm volatile("s_waitcnt lgkmcnt(0)" ::: "memory");
            __builtin_amdgcn_s_barrier();
        }
    }
}

DI void phase_fin(const Frame& F, int j) {
    const bf16_t* YD = (const bf16_t*)(F.ws + C_Y); const float* BS = (const float*)(F.ws + WS_BS); const bf16_t* P = (const bf16_t*)(F.ws + WS_P); const bf16_t* LO = (const bf16_t*)(F.ws + WS_LO); unsigned char* YAB = (unsigned char*)(F.ws + WS_YAB);
    const int ch0 = F.lane * 8; const float eps64 = kf(64e-5f);
    float lg[8], lb[8]; load8f(F.ap->in[18] + j * 512 + ch0, lg); load8f(F.ap->in[19] + j * 512 + ch0, lb);
    float mp[8], mn[8]; load8f(F.ap->in[9] + (size_t)j * A_PROJ + 1024 + ch0, mp); load8f(F.ap->in[10] + (size_t)j * A_PROJ + 1024 + ch0, mn);
    for (int t = F.gw; t < T; t += F.NGW) {
        float yf[8], yb[8], bo[8], ga[8]; unpack8(*(const u32x4*)(YD + (size_t)t * 512 + ch0), yf); unpack8(*(const u32x4*)(YD + ((size_t)T + t) * 512 + ch0), yb); unpack8(*(const u32x4*)(LO + (size_t)t * LORA_N + 2048 + ch0), ga);
        {
            const int tt = t & (SEQ - 1); const bf16_t* pr = P + (size_t)t * AB_PROJ + 1024 + ch0; const float bs = BS[(size_t)t * 8 + (F.lane >> 3)];
            float c[8], pv[8], nv[8]; unpack8(*(const u32x4*)pr, c); unpack8(*(const u32x4*)(pr - (tt > 0 ? AB_PROJ : 0)), pv); unpack8(*(const u32x4*)(pr + (tt < SEQ - 1 ? AB_PROJ : 0)), nv);
#pragma unroll
            for (int i = 0; i < 8; ++i) { const float p0 = tt > 0 ? pv[i] : 0.f, n0 = tt < SEQ - 1 ? nv[i] : 0.f; bo[i] = bs * (c[i] + mp[i] * (p0 - c[i]) + mn[i] * (n0 - c[i])); } }
        float s = 0.f;
#pragma unroll
        for (int i = 0; i < 8; ++i) { yf[i] += yb[i]; s += yf[i]; }
        const float mean = red8(s) * (1.f / 64.f); float q = 0.f;
#pragma unroll
        for (int i = 0; i < 8; ++i) { yf[i] -= mean; q += yf[i] * yf[i]; }
        const float rstd = __builtin_amdgcn_rsqf(red8(q) * (1.f / 64.f) + eps64);
        u32x2 w; float o[8];
#pragma unroll
        for (int i = 0; i < 8; ++i) o[i] = (yf[i] * rstd * lg[i] + lb[i] + bo[i]) * ga[i];
        w.x = pk_fp8x4(o[0], o[1], o[2], o[3]); w.y = pk_fp8x4(o[4], o[5], o[6], o[7]);
        *(u32x2*)(YAB + (size_t)t * D + ch0) = w;
    }
}

DI float other_half(float x, int h) { const u32x2 r = __builtin_amdgcn_permlane32_swap(__builtin_bit_cast(unsigned, x), __builtin_bit_cast(unsigned, x), false, false); return __builtin_bit_cast(float, h ? r.x : r.y); }
DI int crow(int reg, int h) { return (reg & 3) + 8 * (reg >> 2) + 4 * h; }
DI bf16x8 pack_step(const f32x16& x, int s) {
    u32x4 p;
    asm volatile("s_nop 1\n\tv_cvt_pk_bf16_f32 %0, %4, %5\n\tv_cvt_pk_bf16_f32 %1, %6, %7\n\tv_cvt_pk_bf16_f32 %2, %8, %9\n\tv_cvt_pk_bf16_f32 %3, %10, %11\n\ts_nop 1"
                 : "=&v"(p[0]), "=&v"(p[1]), "=&v"(p[2]), "=&v"(p[3])
                 : "v"(x[8 * s]), "v"(x[8 * s + 1]), "v"(x[8 * s + 2]), "v"(x[8 * s + 3]), "v"(x[8 * s + 4]), "v"(x[8 * s + 5]), "v"(x[8 * s + 6]), "v"(x[8 * s + 7]));
    return __builtin_bit_cast(bf16x8, p);
}
DI int t5_bucket(int rel) {
    int n = -rel; const int ret = n < 0 ? 16 : 0; n = n < 0 ? -n : n;
    const int m = (n >= 12) + (n >= 16) + (n >= 23) + (n >= 32) + (n >= 46) + (n >= 64) + (n >= 91);
    return ret + (n < 8 ? n : 8 + m);
}
constexpr int KS_STRIDE = 72, VT_STRIDE = 392;
constexpr int A_KS = 0, A_VT = 384 * KS_STRIDE * 2, A_BIAS = A_VT + 64 * VT_STRIDE * 2, A_END = A_BIAS + 8 * 260 * 4;
static_assert(A_END <= RING_BYTES, "attention LDS");
DI void phase_attn(const Frame& F, int j) {
    const bf16_t* QKV = (const bf16_t*)(F.ws + WS_P); unsigned char* O = (unsigned char*)(F.ws + WS_YAB);
    LAS bf16_t* Ks = (LAS bf16_t*)(F.lds + A_KS); LAS bf16_t* Vt = (LAS bf16_t*)(F.lds + A_VT); LAS float* bT = (LAS float*)(F.lds + A_BIAS);
    const int r = F.lane & 31, h = F.lane >> 5;
    for (int u = F.vcu; u < NB * 2 * 32; u += F.G) {
        const int qb = u & 31, kvh = (u >> 5) & 1, b = u >> 6; const int q0 = qb * 128;
        __syncthreads();
        for (int cidx = F.tid; cidx < 384 * 8; cidx += NTHR) { const int key = cidx >> 3, part = cidx & 7, kp = q0 - 128 + key;
            u32x4 kv = (u32x4){0u, 0u, 0u, 0u}, vv = (u32x4){0u, 0u, 0u, 0u};
            if (kp >= 0 && kp < SEQ) { const bf16_t* row = QKV + (size_t)(b * SEQ + kp) * QKV_N + 1024 + kvh * 64 + part * 8; kv = *(const u32x4*)row; vv = *(const u32x4*)(row + 128); }
            *(LAS u32x4*)(Ks + key * KS_STRIDE + part * 8) = kv;
            const unsigned vw[4] = {vv.x, vv.y, vv.z, vv.w};
#pragma unroll
            for (int i = 0; i < 4; ++i) { Vt[(part * 8 + 2 * i) * VT_STRIDE + key] = (bf16_t)(vw[i] & 0xffffu); Vt[(part * 8 + 2 * i + 1) * VT_STRIDE + key] = (bf16_t)(vw[i] >> 16); } }
        for (int i = F.tid; i < 8 * 257; i += NTHR) { const int hh = i / 257, idx = i % 257; bT[hh * 260 + idx] = F.ap->in[29][t5_bucket(idx - 128) * 16 + kvh * 8 + hh] * 1.44269504f; }
        __syncthreads();
        const int hh = F.wave, head = kvh * 8 + hh; const float sink = F.ap->in[27][j * 16 + head] * 1.44269504f;
        for (int sub = 0; sub < 4; ++sub) {
            const int qrel = 32 * sub + r;
            const size_t qrow = (size_t)(b * SEQ + q0 + qrel);
            bf16x8 Qf[4];
#pragma unroll
            for (int s = 0; s < 4; ++s) Qf[s] = *(const bf16x8*)(QKV + qrow * QKV_N + head * 64 + 16 * s + 8 * h);
            f32x16 O0, O1;
#pragma unroll
            for (int i = 0; i < 16; ++i) { O0[i] = 0.f; O1[i] = 0.f; }
            float mrun = sink, lrun = h ? 0.f : 1.f;
            for (int kt = sub; kt < sub + 9; ++kt) {
                f32x16 x;
#pragma unroll
                for (int i = 0; i < 16; ++i) x[i] = 0.f;
#pragma unroll
                for (int s = 0; s < 4; ++s) { const bf16x8 kf = *(const LAS bf16x8*)(Ks + (32 * kt + r) * KS_STRIDE + 16 * s + 8 * h);
                    x = __builtin_amdgcn_mfma_f32_32x32x16_bf16(kf, Qf[s], x, 0, 0, 0); }
                float mt = -3.0e38f;
                if (kt > sub && kt < sub + 8 && qb > 0 && qb < 31) {
                    const LAS float* bp = bT + hh * 260 + 32 * kt - 32 * sub - r + 4 * h;
#pragma unroll
                    for (int i = 0; i < 16; ++i) { const float sc = x[i] * (0.125f * 1.44269504f) + bp[(i & 3) + 8 * (i >> 2)]; x[i] = sc; mt = fmaxf(mt, sc); }
                } else {
#pragma unroll
                for (int i = 0; i < 16; ++i) { const int kl = 32 * kt + crow(i, h); const int rel = kl - 128 - qrel; const int kp = q0 - 128 + kl;
                    const bool ok = rel >= -128 && rel <= 128 && kp >= 0 && kp < SEQ;
                    const int bi = rel < -128 ? 0 : (rel > 128 ? 256 : rel + 128);
                    const float sc = ok ? x[i] * (0.125f * 1.44269504f) + bT[hh * 260 + bi] : -1e30f; x[i] = sc; mt = fmaxf(mt, sc); }
                }
                mt = fmaxf(mt, other_half(mt, h));
                if (__builtin_amdgcn_ballot_w64(mt > mrun + 8.f) != 0) {
                    const float mnew = fmaxf(mrun, mt); const float alpha = __builtin_amdgcn_exp2f(mrun - mnew); lrun *= alpha; mrun = mnew;
#pragma unroll
                    for (int i = 0; i < 16; ++i) { O0[i] *= alpha; O1[i] *= alpha; } }
                float ps = 0.f;
#pragma unroll
                for (int i = 0; i < 16; ++i) { const float p = __builtin_amdgcn_exp2f(x[i] - mrun); x[i] = p; ps += p; }
                lrun += ps;
#pragma unroll
                for (int s = 0; s < 2; ++s) { const bf16x8 pf = pack_step(x, s);
                    const int kc = 32 * kt + 16 * s + 4 * h;
                    const s16x4 a0l = *(const LAS s16x4*)(Vt + r * VT_STRIDE + kc), a0h = *(const LAS s16x4*)(Vt + r * VT_STRIDE + kc + 8);
                    const s16x4 a1l = *(const LAS s16x4*)(Vt + (32 + r) * VT_STRIDE + kc), a1h = *(const LAS s16x4*)(Vt + (32 + r) * VT_STRIDE + kc + 8);
                    const bf16x8 v0 = __builtin_shufflevector(a0l, a0h, 0, 1, 2, 3, 4, 5, 6, 7), v1 = __builtin_shufflevector(a1l, a1h, 0, 1, 2, 3, 4, 5, 6, 7);
                    O0 = __builtin_amdgcn_mfma_f32_32x32x16_bf16(v0, pf, O0, 0, 0, 0);
                    O1 = __builtin_amdgcn_mfma_f32_32x32x16_bf16(v1, pf, O1, 0, 0, 0); }
            }
            const float inv = __builtin_amdgcn_rcpf(lrun + other_half(lrun, h)); unsigned char* orow = O + qrow * D + head * 64;
#pragma unroll
            for (int g4 = 0; g4 < 4; ++g4) { const int d0 = 8 * g4 + 4 * h;
                *(unsigned*)(orow + d0) = pk_fp8x4(O0[4 * g4] * inv, O0[4 * g4 + 1] * inv, O0[4 * g4 + 2] * inv, O0[4 * g4 + 3] * inv);
                *(unsigned*)(orow + 32 + d0) = pk_fp8x4(O1[4 * g4] * inv, O1[4 * g4 + 1] * inv, O1[4 * g4 + 2] * inv, O1[4 * g4 + 3] * inv); }
        }
    }
}

#ifndef PHMASK
#define PHMASK 0xffff
#endif
#define PM(n) ((PHMASK >> (n)) & 1)
#ifndef REPMASK
#define REPMASK 0
#endif
#define REP(n) for (int rep_ = 0; rep_ < 1 + ((REPMASK >> (n)) & 1); ++rep_)
constexpr int PH_PER_LAYER = 16, PH_BASE = 2, N_PHASES = PH_BASE + DEPTH * PH_PER_LAYER;
__global__ void __launch_bounds__(NTHR, 2) fwd_kernel(Args args) {
    extern __shared__ __attribute__((aligned(16))) unsigned char lds_raw[];
    const int wv = __builtin_amdgcn_readfirstlane((int)threadIdx.x >> 6);
    Frame F = make_frame((LAS unsigned char*)lds_raw, wv);
    for (int u = F.tid; u < (LDS_BYTES - LDSCTL_OFF) / 4; u += NTHR) ((LAS unsigned*)(F.lds + LDSCTL_OFF))[u] = 0u;
    __syncthreads();
    const int lo = F.ap->ph_lo, hi = F.ap->ph_hi;
    unsigned* ctl = (unsigned*)(F.ws + WS_CTL);
    XcdBarrier bar; bar.bar = ctl + CW_BAR; bar.x = 0; bar.st = nullptr;
    if (hi - lo > 1) bar = xcd_barrier_post(ctl + CW_BAR, (volatile LAS unsigned*)(F.lds + L_MISC) + 8, F.tid == 0);
#define IN(k) (lo <= (k) && (k) < hi && ((F = make_frame((LAS unsigned char*)lds_raw, wv)), true))
#define SEAM(k) do { if ((k) + 1 < hi) xcd_barrier(bar, tid_now(wv) == 0); } while (0)
    const LAS int* tile_e = (const LAS int*)(F.lds + L_TILEE); const LAS int* ntl = (const LAS int*)(F.lds + L_NTILES);

    REP(0) if (PM(0)) if (IN(0)) { phase_prologue(F); SEAM(0); }
    REP(1) if (PM(1)) if (IN(1)) { phase_t0(F); SEAM(1); }
    for (int l = 0; l < DEPTH; ++l) {
        const int pb = PH_BASE + l * PH_PER_LAYER, j = l >> 1; const bool even = (l & 1) == 0;
        REP(2) if (PM(2)) if (IN(pb + 0)) {
            const int N = even ? AB_PROJ : QKV_N;
            const bf16_t* Bt = even ? (const bf16_t*)(F.ws + WS_WIN + (size_t)j * AB_PROJ * D) : (const bf16_t*)(F.ws + WS_WQKV + (size_t)j * QKV_N * D);
            pg8::Gemm g{(const bf16_t*)(F.ws + WS_H8), Bt, D / 2}; pg8::TileOrder S; S.init(T / 256, N / 256, F.G, (int)blockIdx.x, nullptr);
            pg8::EpiBf16<false> E{(bf16_t*)(F.ws + WS_P), N, nullptr, 0};
            pg8::gemm_phase<pg8::EpiBf16<false>, 2, true>(F.lds, F.tid, g, S, E);
            SEAM(pb + 0);
        }
        if (even) {
            REP(3) if (PM(3)) if (IN(pb + 1)) { phase_e3a(F, j); SEAM(pb + 1); }
            REP(4) if (PM(4)) if (IN(pb + 2)) {
                pg8::Gemm g{(const bf16_t*)(F.ws + WS_LIN), (const bf16_t*)(F.ws + WS_WLORA) + (size_t)j * LORA_N * LORA_K, LORA_K};
                pg8::TileOrder S; S.init(T / 256, LORA_N / 256, F.G, (int)blockIdx.x, nullptr);
                pg8::EpiBf16<false> E{(bf16_t*)(F.ws + WS_LO), LORA_N, nullptr, 0};
                pg8::gemm_phase<pg8::EpiBf16<false>>(F.lds, F.tid, g, S, E);
                SEAM(pb + 2);
            }
            REP(6) if (PM(6)) if (IN(pb + 4)) { phase_rsub(F, j); SEAM(pb + 4); }
            REP(7) if (PM(7)) if (IN(pb + 5)) { phase_chain(F); SEAM(pb + 5); }
            REP(8) if (PM(8)) if (IN(pb + 6)) { phase_fin(F, j); SEAM(pb + 6); }
        } else {
            REP(9) if (PM(9)) if (IN(pb + 1)) { phase_attn(F, j); SEAM(pb + 1); }
        }
        REP(10) if (PM(10)) if (IN(pb + 7)) {
            const bf16_t* Bt = even ? (const bf16_t*)(F.ws + WS_WOUT + (size_t)j * D * D) : (const bf16_t*)(F.ws + WS_WO + (size_t)j * D * D);
            pg8::Gemm g{(const bf16_t*)(F.ws + WS_YAB), Bt, D / 2}; pg8::TileOrder S; S.init(T / 256, D / 256, F.G, (int)blockIdx.x, nullptr);
            pg8::EpiBf16<false> E{(bf16_t*)(F.ws + WS_Y), D, nullptr, 0};
            pg8::gemm_phase<pg8::EpiBf16<false>, 2, true>(F.lds, F.tid, g, S, E);
            SEAM(pb + 7);
        }
        REP(11) if (PM(11)) if (IN(pb + 8)) { phase_tail(F, l); SEAM(pb + 8); }
        if (IN(pb + 9)) { phase_expert_weights(F, l, 0); SEAM(pb + 9); }
        REP(13) if (PM(13)) if (IN(pb + 10)) {
            moe_tables(F, l);
            pg8::Gemm g{(const bf16_t*)(F.ws + WS_H8), (const bf16_t*)(F.ws + WS_W1 + (size_t)l * NE * 2048 * D), D / 2};
            const pg8::GatherInfo GI{(const int*)(F.ws + WS_SLOTTOK), (const LAS int*)(F.lds + L_CNT), (const LAS int*)(F.lds + L_PSTART)};
            pg8::TileOrder S; S.init(__builtin_amdgcn_readfirstlane(ntl[0]), 2048 / 256, F.G, (int)blockIdx.x, tile_e);
            pg8::EpiSwiglu E{(unsigned char*)(F.ws + WS_A1), FF, (const float*)(F.ws + WS_B1P) + (size_t)l * NE * 2048, 2048};
            pg8::gemm_phase<pg8::EpiSwiglu, 1, true>(F.lds, F.tid, g, S, E, GI);
            SEAM(pb + 10);
        }
        if (IN(pb + 10)) { phase_expert_weights(F, l, 1); SEAM(pb + 10); }
        REP(14) if (PM(14)) if (IN(pb + 11)) {
            moe_tables(F, l);
            pg8::Gemm g{(const bf16_t*)(F.ws + WS_A1), (const bf16_t*)(F.ws + WS_W2 + (size_t)l * NE * D * FF), FF / 2};
            pg8::TileOrder S; S.init(__builtin_amdgcn_readfirstlane(ntl[0]), D / 256, F.G, (int)blockIdx.x, tile_e);
            pg8::EpiF8<true> E{(unsigned char*)(F.ws + WS_XS), D, F.ap->in[35] + (size_t)l * NE * D, D};
            pg8::gemm_phase<pg8::EpiF8<true>, 2, true, 0x7d7d7d7d>(F.lds, F.tid, g, S, E);
            SEAM(pb + 11);
        }
        REP(15) if (PM(15)) if (IN(pb + 12)) { phase_combine(F, l); if (l + 1 < DEPTH) SEAM(pb + 12); }
    }
#undef IN
#undef SEAM
}

#ifndef N_RUN_PHASES
#define N_RUN_PHASES N_PHASES
#endif
#ifndef ONE_LAUNCH
#define ONE_LAUNCH 1
#endif
extern "C" void kernel_launch(void* const* d_in, const int* in_sizes, int n_in, void* d_out, int out_size, void* d_ws, size_t ws_size, hipStream_t stream) {
    static int grid = 0;
    if (grid == 0) {
        if (n_in != 36 || out_size != T * D || ws_size < WS_END) { fprintf(stderr, "kernel_launch: unexpected sizes n_in %d out %d ws %zu (need %zu)\n", n_in, out_size, ws_size, (size_t)WS_END); grid = -1; return; }
        int dev = 0, cus = 0, per_cu = 0;
        if (hipGetDevice(&dev) != hipSuccess || hipDeviceGetAttribute(&cus, hipDeviceAttributeMultiprocessorCount, dev) != hipSuccess) { grid = -1; return; }
        if (hipFuncSetAttribute((const void*)fwd_kernel, hipFuncAttributeMaxDynamicSharedMemorySize, LDS_BYTES) != hipSuccess) { fprintf(stderr, "kernel_launch: hipFuncSetAttribute failed\n"); grid = -1; return; }
        if (hipOccupancyMaxActiveBlocksPerMultiprocessor(&per_cu, (const void*)fwd_kernel, NTHR, LDS_BYTES) != hipSuccess || per_cu < 1) { fprintf(stderr, "kernel_launch: occupancy query reports %d\n", per_cu); }
        (void)hipGetLastError();
        grid = cus;
    }
    if (grid < 0) return;
    (void)hipMemsetAsync((char*)d_ws + WS_CTL, 0, CTL_ZERO_BYTES, stream);
    Args a{};
    for (int i = 0; i < 36; ++i) a.in[i] = (const float*)d_in[i];
    a.out = (float*)d_out; a.ws = (unsigned char*)d_ws;
#if ONE_LAUNCH
    a.ph_lo = 0; a.ph_hi = N_RUN_PHASES;
    hipLaunchKernelGGL(fwd_kernel, dim3(grid), dim3(NTHR), LDS_BYTES, stream, a);
#else
    for (int k = 0; k < N_RUN_PHASES; ++k) {
        if (k >= PH_BASE) { const int l = (k - PH_BASE) / PH_PER_LAYER, p = (k - PH_BASE) % PH_PER_LAYER; if (p > 12 || p == 9 || p == 3) continue; if ((l & 1) && p >= 2 && p <= 6) continue; }
        a.ph_lo = k; a.ph_hi = k + 1;
        hipLaunchKernelGGL(fwd_kernel, dim3(grid), dim3(NTHR), LDS_BYTES, stream, a);
    }
#endif
}
```

```cpp
#include <hip/hip_runtime.h>
#include <cstdio>
#include <cstdint>

#define GAS __attribute__((address_space(1)))
#define LAS __attribute__((address_space(3)))
#define CAS __attribute__((address_space(4)))
#define DI __device__ __forceinline__

typedef unsigned short bf16_t;
typedef short bf16x8 __attribute__((ext_vector_type(8)));
typedef short s16x4 __attribute__((ext_vector_type(4)));
typedef float f32x2 __attribute__((ext_vector_type(2)));
typedef float f32x4 __attribute__((ext_vector_type(4)));
typedef float f32x16 __attribute__((ext_vector_type(16)));
typedef unsigned u32x2 __attribute__((ext_vector_type(2)));
typedef unsigned u32x4 __attribute__((ext_vector_type(4)));
typedef int i32x4 __attribute__((ext_vector_type(4)));
typedef int i32x8 __attribute__((ext_vector_type(8)));

constexpr int NB = 8, SEQ = 4096, D = 1024, T = NB * SEQ, DEPTH = 4;
constexpr int RW = 512, RH = 8, A_PROJ = 1792, AB_PROJ = 2816, LORA_N = 2560, LORA_K = 256;
constexpr int QKV_N = 1280, NE = 32, FF = 1024;
constexpr int NCH = 16, CHL = SEQ / NCH;
constexpr int NSEQ = NB * RH * 2;
constexpr int MAX_TILES = 544, MAX_SLOTS = MAX_TILES * 256;
constexpr int NWAVES = 8, NTHR = 512;

constexpr size_t MiB = 1u << 20;
constexpr size_t WS_CTL = 0, CTL_ZERO_BYTES = 1 * MiB;
constexpr int CW_BAR = 4096;
constexpr int CW_GCNT = 16384;
constexpr size_t WS_MOD = 1 * MiB;
constexpr size_t WS_RWT = 2 * MiB;
constexpr size_t WS_B1P = 3 * MiB;
constexpr size_t WS_TOKE = 4 * MiB;
constexpr size_t WS_TOKP = 5 * MiB;
constexpr size_t WS_TOKG = 6 * MiB;
constexpr size_t WS_TOKS = 7 * MiB;
constexpr size_t WS_SLOTTOK = 40 * MiB;
constexpr size_t WS_WLORA = 8 * MiB;
constexpr size_t WS_WIN = 12 * MiB;
constexpr size_t WS_WOUT = 24 * MiB;
constexpr size_t WS_WQKV = 28 * MiB;
constexpr size_t WS_WO = 34 * MiB;
constexpr size_t WS_W1 = 64 * MiB;
constexpr size_t WS_W2 = 576 * MiB;
constexpr size_t WS_H = 832 * MiB;
constexpr size_t WS_P = 896 * MiB;
constexpr size_t WS_LIN = 1072 * MiB;
constexpr size_t WS_LO = 1088 * MiB;
constexpr size_t WS_RS = 1248 * MiB;
constexpr size_t WS_RD = 1440 * MiB;
constexpr size_t WS_BS = 1824 * MiB;
constexpr size_t WS_YL = 1952 * MiB;
constexpr size_t WS_ZZ = 2080 * MiB;
constexpr size_t WS_GL = 2208 * MiB;
constexpr size_t WS_UL = 2240 * MiB;
constexpr size_t WS_SS = 2272 * MiB;
constexpr size_t WS_YAB = 2304 * MiB;
constexpr size_t WS_Y = 2368 * MiB;
constexpr size_t WS_XS = 2432 * MiB;
constexpr size_t WS_A1 = 2704 * MiB;
constexpr size_t WS_SC2 = 2976 * MiB;
constexpr size_t SC2_RS = 0, SC2_RD = 192 * MiB, SC2_ZZ = 576 * MiB, SC2_GL = 704 * MiB;
constexpr size_t WS_XB = 3712 * MiB;
constexpr size_t WS_H8 = 3776 * MiB;
constexpr size_t WS_END = 3808 * MiB;

constexpr int RING_BYTES = 131072;
constexpr int LDSCTL_OFF = RING_BYTES;
constexpr int L_MISC = LDSCTL_OFF;
constexpr int L_HIST = LDSCTL_OFF + 256;
constexpr int L_BASE = LDSCTL_OFF + 384;
constexpr int L_PSTART = LDSCTL_OFF + 512;
constexpr int L_NTILES = LDSCTL_OFF + 704;
constexpr int L_CNT = LDSCTL_OFF + 768;
constexpr int L_TILEE = LDSCTL_OFF + 1024;
constexpr int LDS_BYTES = 147456;

DI float bf2f(unsigned v) { return __builtin_bit_cast(float, v << 16); }
DI float kf(float c) { asm volatile("" : "+v"(c)); return c; }
DI int ki(int c) { asm volatile("" : "+v"(c)); return c; }
DI int shfl_src(int x, int src_lane) { return __builtin_amdgcn_ds_bpermute(src_lane << 2, x); }
DI unsigned f2bf(float f) { unsigned u = __builtin_bit_cast(unsigned, f); return (u + 0x7fffu + ((u >> 16) & 1u)) >> 16; }
DI unsigned pk2(float lo, float hi) { return f2bf(lo) | (f2bf(hi) << 16); }
typedef __bf16 bfv2_ __attribute__((ext_vector_type(2)));
DI unsigned cvtb2(float lo, float hi) { return __builtin_bit_cast(unsigned, __builtin_convertvector((f32x2){lo, hi}, bfv2_)); }
DI unsigned cvt_pk_bf16(float lo, float hi) { unsigned r; asm volatile("v_cvt_pk_bf16_f32 %0, %1, %2" : "=v"(r) : "v"(lo), "v"(hi)); return r; }
#define DPP_ADD(x, ctrl) ((x) + __builtin_bit_cast(float, __builtin_amdgcn_update_dpp(0, __builtin_bit_cast(int, (x)), (ctrl), 0xf, 0xf, true)))
DI unsigned pk_fp8x4(float a, float b, float c, float d) { int p = 0; p = __builtin_amdgcn_cvt_pk_fp8_f32(a, b, p, false); p = __builtin_amdgcn_cvt_pk_fp8_f32(c, d, p, true); return (unsigned)p; }
constexpr float W8_SCALE = 64.f;
DI float wave_sum(float v) {
    v = DPP_ADD(v, 0xB1); v = DPP_ADD(v, 0x4E); v = DPP_ADD(v, 0x141); v = DPP_ADD(v, 0x140);
    const int vi = __builtin_bit_cast(int, v);
    return (__builtin_bit_cast(float, __builtin_amdgcn_readlane(vi, 0)) + __builtin_bit_cast(float, __builtin_amdgcn_readlane(vi, 16))) + (__builtin_bit_cast(float, __builtin_amdgcn_readlane(vi, 32)) + __builtin_bit_cast(float, __builtin_amdgcn_readlane(vi, 48)));
}
DI float sigmoidf_(float x) { return __builtin_amdgcn_rcpf(1.f + __expf(-x)); }
DI float tanhf_(float x) { return 1.f - 2.f * __builtin_amdgcn_rcpf(1.f + __expf(2.f * x)); }
DI const CAS float* as_const(const float* p) { return (const CAS float*)(unsigned long long)p; }
#define LDS_WAIT() asm volatile("s_waitcnt lgkmcnt(0)" ::: "memory")
#define VM_WAIT() asm volatile("s_waitcnt vmcnt(0)" ::: "memory")

#define XB_TMO      128
#define XB_XCNT(j)  (256  + 64 * (j))
#define XB_XSUB(j)  (1280 + 64 * (j))
#define XB_XGEN(j)  (2304 + 64 * (j))
#define XB_TOP      3328
#define XB_TOPGEN   3392
#define XCD_BAR_WORDS 3456
#define XB_SPIN_CAP (1u << 18)
DI unsigned xb_ld(unsigned* p)              { return __hip_atomic_load(p, __ATOMIC_RELAXED, __HIP_MEMORY_SCOPE_AGENT); }
DI unsigned xb_add(unsigned* p, unsigned v) { return __hip_atomic_fetch_add(p, v, __ATOMIC_RELAXED, __HIP_MEMORY_SCOPE_AGENT); }
DI unsigned xb_xcc_id() { return (unsigned)__builtin_amdgcn_s_getreg((3 << 11) | 20) & 0xFu; }
#define XB_SPIN(cond, bar) do { unsigned _sp = 0; while (cond) { __builtin_amdgcn_s_sleep(1); \
    if ((++_sp & 255u) == 0u) { if (xb_ld(&(bar)[XB_TMO])) break; if (_sp > XB_SPIN_CAP) { atomicAdd(&(bar)[XB_TMO], 1u); break; } } } } while (0)
struct XcdBarrier { unsigned* bar; unsigned x; volatile LAS unsigned* st; };
DI XcdBarrier xcd_barrier_post(unsigned* bar, volatile LAS unsigned* st, const bool leader) {
    XcdBarrier b; b.bar = bar; b.x = xb_xcc_id(); b.st = st;
    if (leader) (void)xb_add(&bar[XB_XCNT(b.x)], 1u);
    return b;
}
DI void xcd_barrier_complete(unsigned* bar, unsigned x, unsigned& nloc, unsigned& nx) {
    const unsigned G = gridDim.x * gridDim.y * gridDim.z;
    unsigned sum, cnt, mine, sp = 0u;
    for (;;) {
        sum = 0u; cnt = 0u; mine = 0u;
#pragma unroll
        for (unsigned j = 0; j < 16; ++j) { const unsigned c = xb_ld(&bar[XB_XCNT(j)]); sum += c; cnt += (c > 0u) ? 1u : 0u; mine = (j == x) ? c : mine; }
        if (sum == G) break;
        __builtin_amdgcn_s_sleep(1);
        if ((++sp & 255u) == 0u) { if (xb_ld(&bar[XB_TMO])) break; if (sp > XB_SPIN_CAP) { atomicAdd(&bar[XB_TMO], 1u); break; } }
    }
    nloc = mine > 0u ? mine : 1u; nx = cnt > 0u ? cnt : 1u;
}
DI void xcd_barrier(const XcdBarrier& b, const bool leader) {
    asm volatile("s_waitcnt vmcnt(0)" ::: "memory");
    __syncthreads();
    if (leader) {
        unsigned* bar = b.bar;
        __builtin_amdgcn_s_waitcnt(0);
        unsigned nloc = b.st[0], nx = b.st[1];
        if (nloc == 0u) { xcd_barrier_complete(bar, b.x, nloc, nx); b.st[0] = nloc; b.st[1] = nx; }
        const unsigned old = xb_add(&bar[XB_XSUB(b.x)], 1u);
        const unsigned gen = old / nloc;
        if (old + 1u == (gen + 1u) * nloc) {
            __builtin_amdgcn_fence(__ATOMIC_RELEASE, "agent");
            asm volatile("s_waitcnt vmcnt(0)" ::: "memory");
            const unsigned og = xb_add(&bar[XB_TOP], 1u);
            const unsigned tg = og / nx;
            if (og + 1u == (tg + 1u) * nx) xb_add(&bar[XB_TOPGEN], 1u);
            else XB_SPIN(xb_ld(&bar[XB_TOPGEN]) == tg, bar);
            __builtin_amdgcn_fence(__ATOMIC_ACQUIRE, "agent");
            xb_add(&bar[XB_XGEN(b.x)], 1u);
            asm volatile("s_waitcnt vmcnt(0)" ::: "memory");
        } else {
            XB_SPIN(xb_ld(&bar[XB_XGEN(b.x)]) == gen, bar);
            __builtin_amdgcn_fence(__ATOMIC_ACQUIRE, "agent");
            asm volatile("s_waitcnt vmcnt(0)" ::: "memory");
        }
    }
    __syncthreads();
}

namespace pg8 {
constexpr int BM = 256, BK = 64, HALF = 128, HTB = HALF * BK * 2, STAGE_BYTES = 8 * HTB, NXCD = 8, WGM = 8;
__host__ __device__ __forceinline__ int lds_byte(int r, int c) { const int st = (r >> 4) * 2 + (c >> 5), rr = r & 15, cc = c & 31, ob = rr * 64 + cc * 2; return st * 1024 + (ob ^ (((ob >> 9) & 1) << 5)); }
__host__ __device__ __forceinline__ void stage_rc(int b, int& R, int& C) { const int st = b / 1024, sb = b % 1024, swz = sb ^ (((sb >> 9) & 1) << 5); R = (st >> 1) * 16 + swz / 64; C = (st & 1) * 32 + (swz % 64) / 2; }
__host__ __device__ __forceinline__ int perm32(int rho) { const int n = rho >> 4, i = rho & 15; return 8 * (i >> 2) + 4 * n + (i & 3); }

struct Unit { int pm, pn, pb, e; };
struct Gemm { const bf16_t* A; const bf16_t* Bt; int K; };

struct TileOrder {
    int nM, nN, nwg, G, c, wgm; const LAS int* tile_e;
    DI void init(int nM_, int nN_, int G_, int c_, const LAS int* te) { nM = nM_; nN = nN_; nwg = nM * nN; G = G_; c = c_; tile_e = te; wgm = (32 + nN / 2) / nN; if (wgm < 1) wgm = 1; }
    DI bool next(int i, Unit& u) const {
        const long L = (long)i * G + c; if (L >= nwg) return false;
        int wgid = (int)L; { const int q = nwg / NXCD, r = nwg % NXCD, xcd = wgid % NXCD, off = wgid / NXCD; wgid = (xcd < r ? xcd * (q + 1) : r * (q + 1) + (xcd - r) * q) + off; }
        const int nig = wgm * nN, gid = wgid / nig, fm = gid * wgm, gsz = (nM - fm) < wgm ? (nM - fm) : wgm;
        u.pm = fm + ((wgid % nig) % gsz); u.pn = (wgid % nig) / gsz;
        if (tile_e) { u.e = __builtin_amdgcn_readfirstlane(tile_e[u.pm]); u.pb = u.e * nN + u.pn; } else { u.e = 0; u.pb = u.pn; }
        return true;
    }
};

template <class P> DI void acc_init_from(f32x4 (&acc)[2][2][4][2], P bp, const float bscale) {
    f32x4 bv[2][2];
#pragma unroll
    for (int bj = 0; bj < 2; ++bj)
#pragma unroll
        for (int n = 0; n < 2; ++n) bv[bj][n] = bp[(bj * HALF + 4 * n) / 4] * bscale;
#pragma unroll
    for (int a = 0; a < 2; ++a)
#pragma unroll
        for (int b = 0; b < 2; ++b)
#pragma unroll
            for (int m = 0; m < 4; ++m)
#pragma unroll
                for (int n = 0; n < 2; ++n) acc[a][b][m][n] = bv[b][n];
}
DI void acc_zero(f32x4 (&acc)[2][2][4][2]) {
#pragma unroll
    for (int a = 0; a < 2; ++a)
#pragma unroll
        for (int b = 0; b < 2; ++b)
#pragma unroll
            for (int m = 0; m < 4; ++m)
#pragma unroll
                for (int n = 0; n < 2; ++n) acc[a][b][m][n] = (f32x4){0.f, 0.f, 0.f, 0.f};
}
template <bool HAS_BIAS> struct EpiBf16 {
    static constexpr bool PERM = true;
    static constexpr float OSCALE = 1.f;
    bf16_t* O; int ldc; const float* bias; int bias_stride;
    static constexpr bool HASB = HAS_BIAS;
    DI const float* bias_ptr(const Unit& u) const { return bias + (size_t)u.e * bias_stride + u.pn * BM; }
    DI void operator()(const f32x4 (&acc)[2][2][4][2], const Unit& u, int wr, int wc, int fr, int fq) const {
        const int row0 = u.pm * BM + wr * 64 + fr; const int col0 = u.pn * BM + wc * 32 + 8 * fq;
#pragma unroll
        for (int ai = 0; ai < 2; ++ai)
#pragma unroll
            for (int m = 0; m < 4; ++m) { bf16_t* rowp = O + (size_t)(row0 + ai * HALF + m * 16) * ldc + col0;
#pragma unroll
                for (int bj = 0; bj < 2; ++bj) { const f32x4 v0 = acc[ai][bj][m][0], v1 = acc[ai][bj][m][1];
                    u32x4 w; w.x = cvtb2(v0[0], v0[1]); w.y = cvtb2(v0[2], v0[3]); w.z = cvtb2(v1[0], v1[1]); w.w = cvtb2(v1[2], v1[3]);
                    *(u32x4*)(rowp + bj * HALF) = w; } }
    }
};
template <bool HAS_BIAS> struct EpiF8 {
    static constexpr bool PERM = true;
    static constexpr float OSCALE = 16.f;
    unsigned char* O; int ldc; const float* bias; int bias_stride;
    static constexpr bool HASB = HAS_BIAS;
    DI const float* bias_ptr(const Unit& u) const { return bias + (size_t)u.e * bias_stride + u.pn * BM; }
    DI void operator()(const f32x4 (&acc)[2][2][4][2], const Unit& u, int wr, int wc, int fr, int fq) const {
        const int row0 = u.pm * BM + wr * 64 + fr; const int col0 = u.pn * BM + wc * 32 + 8 * (fq & ~1) + (fq & 1) * HALF; const float cmax = kf(448.f);
#pragma unroll
        for (int ai = 0; ai < 2; ++ai)
#pragma unroll
            for (int m = 0; m < 4; ++m) { unsigned char* rowp = O + (size_t)(row0 + ai * HALF + m * 16) * ldc + col0;
                u32x2 w[2];
#pragma unroll
                for (int bj = 0; bj < 2; ++bj) { f32x4 v0 = acc[ai][bj][m][0], v1 = acc[ai][bj][m][1];
#pragma unroll
                    for (int i = 0; i < 4; ++i) { v0[i] = __builtin_amdgcn_fmed3f(v0[i], -cmax, cmax); v1[i] = __builtin_amdgcn_fmed3f(v1[i], -cmax, cmax); }
                    w[bj].x = pk_fp8x4(v0[0], v0[1], v0[2], v0[3]); w[bj].y = pk_fp8x4(v1[0], v1[1], v1[2], v1[3]); }
                const u32x2 sx = __builtin_amdgcn_permlane16_swap(w[0].x, w[1].x, false, false), sy = __builtin_amdgcn_permlane16_swap(w[0].y, w[1].y, false, false);
                *(u32x4*)rowp = (u32x4){sx.x, sy.x, sx.y, sy.y}; }
    }
};
struct EpiSwiglu {
    static constexpr bool PERM = true;
    static constexpr float OSCALE = 1.f;
    unsigned char* O; int ldc; const float* bias; int bias_stride;
    static constexpr bool HASB = true;
    DI const float* bias_ptr(const Unit& u) const { return bias + (size_t)u.e * bias_stride + u.pn * BM; }
    DI void operator()(const f32x4 (&acc)[2][2][4][2], const Unit& u, int wr, int wc, int fr, int fq) const {
        const int row0 = u.pm * BM + wr * 64 + fr + (fq & 1) * 16; const int col0 = u.pn * HALF + wc * 32 + 8 * (fq & ~1); const float c7 = kf(7.f);
#pragma unroll
        for (int ai = 0; ai < 2; ++ai)
#pragma unroll
            for (int mp = 0; mp < 2; ++mp) { unsigned char* rowp = O + (size_t)(row0 + ai * HALF + mp * 32) * ldc + col0;
                u32x2 w[2];
#pragma unroll
                for (int mm = 0; mm < 2; ++mm) { const int m = 2 * mp + mm; float o[8];
#pragma unroll
                    for (int n = 0; n < 2; ++n) { const f32x4 g = acc[ai][0][m][n], l = acc[ai][1][m][n];
#pragma unroll
                        for (int jp = 0; jp < 2; ++jp) {
                            const f32x2 xg = __builtin_elementwise_min((f32x2){g[2 * jp], g[2 * jp + 1]}, (f32x2){c7, c7});
                            const f32x2 xl = __builtin_elementwise_min(__builtin_elementwise_max((f32x2){l[2 * jp], l[2 * jp + 1]}, (f32x2){-c7, -c7}), (f32x2){c7, c7});
                            const f32x2 z = xg * (-1.702f * 1.44269504f); f32x2 e; e.x = __builtin_amdgcn_exp2f(z.x); e.y = __builtin_amdgcn_exp2f(z.y);
                            const f32x2 dn = e + 1.f; f32x2 rc; rc.x = __builtin_amdgcn_rcpf(dn.x); rc.y = __builtin_amdgcn_rcpf(dn.y);
                            const f32x2 r2 = (xg * rc) * (xl + 1.f); o[n * 4 + 2 * jp] = r2.x; o[n * 4 + 2 * jp + 1] = r2.y; } }
                    w[mm].x = pk_fp8x4(o[0], o[1], o[2], o[3]); w[mm].y = pk_fp8x4(o[4], o[5], o[6], o[7]); }
                const u32x2 sx = __builtin_amdgcn_permlane16_swap(w[0].x, w[1].x, false, false), sy = __builtin_amdgcn_permlane16_swap(w[0].y, w[1].y, false, false);
                *(u32x4*)rowp = (u32x4){sx.x, sy.x, sx.y, sy.y}; }
    }
};

constexpr int CAPX = 32768;
struct GatherInfo { const int* slot_tok; const LAS int* cnt; const LAS int* pstart; };
DI void gather_offs_direct(const GatherInfo& GI, const Unit& u, int tid, int K, unsigned (&o0)[2], unsigned (&o1)[2]) {
    const int e = u.e, lt = u.pm - (__builtin_amdgcn_readfirstlane(GI.pstart[e]) >> 8), cnt = __builtin_amdgcn_readfirstlane(GI.cnt[e]);
    const int* st = GI.slot_tok + (size_t)e * CAPX;
#pragma unroll
    for (int i = 0; i < 2; ++i) { int R, C; stage_rc(tid * 16 + i * 8192, R, C);
        const int r0 = lt * 256 + R, r1 = r0 + HALF; const int t0 = st[r0 < cnt ? r0 : 0], t1 = st[r1 < cnt ? r1 : 0];
        o0[i] = (unsigned)((r0 < cnt ? t0 : 0) * K + C) * 2u; o1[i] = (unsigned)((r1 < cnt ? t1 : 0) * K + C) * 2u; }
}
DI void gather_issue(const GatherInfo& GI, const Unit& u, int wid, int lane, LAS unsigned char* idx) {
    if (wid < 4) { const int e = u.e, lt = u.pm - (__builtin_amdgcn_readfirstlane(GI.pstart[e]) >> 8);
        __builtin_amdgcn_global_load_lds((const unsigned*)(GI.slot_tok + (size_t)e * CAPX + lt * 256 + wid * 64 + lane), (LAS unsigned*)(idx + wid * 256), 4, 0, 0); }
}
DI void gather_offs_lds(const GatherInfo& GI, const Unit& u, int tid, int K, const LAS unsigned char* idx, unsigned (&o0)[2], unsigned (&o1)[2]) {
    const int e = u.e, lt = u.pm - (__builtin_amdgcn_readfirstlane(GI.pstart[e]) >> 8), cnt = __builtin_amdgcn_readfirstlane(GI.cnt[e]);
#pragma unroll
    for (int i = 0; i < 2; ++i) { int R, C; stage_rc(tid * 16 + i * 8192, R, C);
        const int r0 = lt * 256 + R, r1 = r0 + HALF; const int t0 = *(const LAS int*)(idx + R * 4), t1 = *(const LAS int*)(idx + (HALF + R) * 4);
        o0[i] = (unsigned)((r0 < cnt ? t0 : 0) * K + C) * 2u; o1[i] = (unsigned)((r1 < cnt ? t1 : 0) * K + C) * 2u; }
}
DI void tile_offs(const Unit& u, int tid, int K, unsigned (&o0)[2], unsigned (&o1)[2]) {
#pragma unroll
    for (int i = 0; i < 2; ++i) { int R, C; stage_rc(tid * 16 + i * 8192, R, C);
        o0[i] = (unsigned)((u.pm * 256 + R) * K + C) * 2u; o1[i] = (unsigned)((u.pm * 256 + HALF + R) * K + C) * 2u; }
}
template <class Epi, int GATHER = 0, bool FP8 = false, int SCALE_A = 0x79797979>
DI void gemm_phase(LAS unsigned char* lds, const int tid_in, const Gemm g, const TileOrder& S, const Epi& E, const GatherInfo GI = GatherInfo{nullptr, nullptr, nullptr}) {
    int tid = tid_in; asm volatile("" : "+v"(tid));
    const int wid = __builtin_amdgcn_readfirstlane(tid >> 6), lane = tid & 63, wr = wid >> 2, wc = wid & 3, fr = lane & 15, fq = lane >> 4;
    const int K = g.K, nt = K / BK;
    unsigned vA0[2], vA1[2], voffB[2];
    const size_t kstep = (size_t)(BK * 2);
    const size_t hstep = (size_t)HALF * K * 2;
#pragma unroll
    for (int i = 0; i < 2; ++i) { int R, C; stage_rc(tid * 16 + i * 8192, R, C); const int Rb = Epi::PERM ? ((R & ~31) + perm32(R & 31)) : R;
        vA0[i] = (unsigned)(R * K + C) * 2u; vA1[i] = vA0[i] + (unsigned)hstep; voffB[i] = (unsigned)(Rb * K + C) * 2u; }
    const size_t tstep = 2 * hstep;
    const unsigned ldsw = (unsigned)wid * 1024u;
    const int aoff = lds_byte(wr * 64 + fr, fq * 8), boff = lds_byte(wc * 32 + fr, fq * 8);
#define PG8_SA(b, h) (((b) * 2 + (h)) * HTB)
#define PG8_SB(b, h) ((4 + (b) * 2 + (h)) * HTB)
#define PG8_STAGE(bufoff, gbase, voff) do { _Pragma("unroll") for (int _i = 0; _i < 2; ++_i) \
        __builtin_amdgcn_global_load_lds((const unsigned*)((const char*)(gbase) + (voff)[_i]), (LAS unsigned*)(lds + (bufoff) + ldsw + _i * 8192), 16, 0, 0); } while (0)
#define PG8_LDA(dst, b, h) do { _Pragma("unroll") for (int m = 0; m < 4; ++m) _Pragma("unroll") for (int k = 0; k < 2; ++k) dst[m][k] = *(const LAS bf16x8*)(lds + PG8_SA(b, h) + aoff + m * 2048 + k * 1024); } while (0)
#define PG8_LDB(dst, b, h) do { _Pragma("unroll") for (int n = 0; n < 2; ++n) _Pragma("unroll") for (int k = 0; k < 2; ++k) dst[n][k] = *(const LAS bf16x8*)(lds + PG8_SB(b, h) + boff + n * 2048 + k * 1024); } while (0)
#define PG8_MMA(ai, bj, At, Bt) do { __builtin_amdgcn_sched_barrier(0); __builtin_amdgcn_s_setprio(1); _Pragma("unroll") for (int m = 0; m < 4; ++m) _Pragma("unroll") for (int n = 0; n < 2; ++n) { \
        if constexpr (FP8) acc[ai][bj][m][n] = __builtin_amdgcn_mfma_scale_f32_16x16x128_f8f6f4(__builtin_shufflevector(__builtin_bit_cast(i32x4, Bt[n][0]), __builtin_bit_cast(i32x4, Bt[n][1]), 0, 1, 2, 3, 4, 5, 6, 7), \
                __builtin_shufflevector(__builtin_bit_cast(i32x4, At[m][0]), __builtin_bit_cast(i32x4, At[m][1]), 0, 1, 2, 3, 4, 5, 6, 7), acc[ai][bj][m][n], 0, 0, 0, sc_w, 0, sc_a); \
        else { _Pragma("unroll") for (int k = 0; k < 2; ++k) acc[ai][bj][m][n] = __builtin_amdgcn_mfma_f32_16x16x32_bf16(Bt[n][k], At[m][k], acc[ai][bj][m][n], 0, 0, 0); } } \
        __builtin_amdgcn_s_setprio(0); __builtin_amdgcn_sched_barrier(0); } while (0)
#define PG8_WAIT_V(n) asm volatile("s_waitcnt vmcnt(" #n ")" ::: "memory")
#define PG8_WAIT_L(n) asm volatile("s_waitcnt lgkmcnt(" #n ")" ::: "memory")
#define PG8_BAR __builtin_amdgcn_s_barrier()
#define PG8_SCHED __builtin_amdgcn_sched_barrier(0)
    const int sc_w = ki(SCALE_A), sc_a = ki(0x7f7f7f7f);
    Unit cur, nxt; int ui = 0;
    if (!S.next(0, cur)) return;
    f32x4 acc[2][2][4][2];
    if constexpr (Epi::HASB) acc_init_from(acc, (const f32x4*)(E.bias_ptr(cur) + wc * 32 + 8 * fq), Epi::OSCALE); else acc_zero(acc);
    bf16x8 At[4][2], B0[2][2], B1[2][2];
    const char* cA = GATHER ? (const char*)g.A : (const char*)g.A + (size_t)cur.pm * tstep;
    if constexpr (GATHER == 2) tile_offs(cur, tid, K, vA0, vA1); const char* cB = (const char*)g.Bt + (size_t)cur.pb * tstep;
    LAS unsigned char* utab = lds + STAGE_BYTES + 4096;
    if constexpr (GATHER == 1) gather_offs_direct(GI, cur, tid, K, vA0, vA1);
    PG8_STAGE(PG8_SB(0, 0), cB, voffB); PG8_STAGE(PG8_SB(0, 1), cB + hstep, voffB); PG8_STAGE(PG8_SA(0, 0), cA, vA0); PG8_STAGE(PG8_SA(0, 1), cA, vA1);
    if (wr == 1) PG8_BAR;
    PG8_WAIT_V(2); PG8_BAR;
    PG8_STAGE(PG8_SB(1, 0), cB + kstep, voffB); PG8_STAGE(PG8_SA(1, 0), cA + kstep, vA0); PG8_STAGE(PG8_SB(1, 1), cB + hstep + kstep, voffB);
    PG8_WAIT_V(6); PG8_BAR;
    for (;;) {
        const bool has_next = S.next(ui + 1, nxt);
        const char* nA = GATHER ? cA : (has_next ? (const char*)g.A + (size_t)nxt.pm * tstep : cA); const char* nB = has_next ? (const char*)g.Bt + (size_t)nxt.pb * tstep : cB;
        LAS unsigned char* ntab = utab + ((ui + 1) & 1) * 2048;
        if constexpr (GATHER == 1) { if (has_next) gather_issue(GI, nxt, wid, lane, ntab); }
        if constexpr (Epi::HASB) { if (has_next && wid >= 4) __builtin_amdgcn_global_load_lds((const unsigned*)(E.bias_ptr(nxt) + (wid - 4) * 64 + lane), (LAS unsigned*)(ntab + 1024 + (wid - 4) * 256), 4, 0, 0); }
        for (int t = 0; t < nt; t += 2) {
            const bool last = (t == nt - 2);
            const char* a1 = cA + (size_t)(t + 1) * kstep;
            const char* a2 = last ? nA : cA + (size_t)(t + 2) * kstep; const char* b2 = last ? nB : cB + (size_t)(t + 2) * kstep;
            const char* a3 = a2 + kstep; const char* b3 = b2 + kstep;
            PG8_LDB(B0, 0, 0); PG8_LDB(B1, 0, 1); PG8_SCHED; PG8_LDA(At, 0, 0); PG8_STAGE(PG8_SA(1, 1), a1, vA1);
            if constexpr (GATHER == 1) { if (last && has_next) gather_offs_lds(GI, nxt, tid, K, ntab, vA0, vA1); }
            if constexpr (GATHER == 2) { if (last && has_next) tile_offs(nxt, tid, K, vA0, vA1); }
            PG8_WAIT_V(8); PG8_WAIT_L(0); PG8_BAR; PG8_MMA(0, 0, At, B0); PG8_MMA(0, 1, At, B1); PG8_BAR; PG8_SCHED;
            PG8_LDA(At, 0, 1); PG8_STAGE(PG8_SB(0, 0), b2, voffB); PG8_STAGE(PG8_SB(0, 1), b2 + hstep, voffB); PG8_STAGE(PG8_SA(0, 0), a2, vA0);
            PG8_WAIT_V(8); PG8_WAIT_L(0); PG8_BAR; PG8_MMA(1, 0, At, B0); PG8_MMA(1, 1, At, B1); PG8_BAR; PG8_SCHED;
            PG8_LDB(B0, 1, 0); PG8_LDB(B1, 1, 1); PG8_SCHED; PG8_LDA(At, 1, 0); PG8_STAGE(PG8_SA(0, 1), a2, vA1);
            PG8_WAIT_V(8); PG8_WAIT_L(0); PG8_BAR; PG8_MMA(0, 0, At, B0); PG8_MMA(0, 1, At, B1); PG8_BAR; PG8_SCHED;
            PG8_LDA(At, 1, 1); PG8_STAGE(PG8_SB(1, 0), b3, voffB); PG8_STAGE(PG8_SB(1, 1), b3 + hstep, voffB); PG8_STAGE(PG8_SA(1, 0), a3, vA0);
            PG8_WAIT_V(8); PG8_WAIT_L(0); PG8_BAR; PG8_MMA(1, 0, At, B0); PG8_MMA(1, 1, At, B1); PG8_BAR; PG8_SCHED;
        }
        if (wr == 0) PG8_BAR;
        { int l2; asm volatile("v_mbcnt_lo_u32_b32 %0, -1, 0\n\tv_mbcnt_hi_u32_b32 %0, -1, %0" : "=v"(l2)); E(acc, cur, wr, wc, l2 & 15, l2 >> 4); }
        if (!has_next) break;
        if constexpr (Epi::HASB) acc_init_from(acc, (const LAS f32x4*)(ntab + 1024 + (wc * 32 + 8 * fq) * 4), Epi::OSCALE); else acc_zero(acc);
        cur = nxt; cA = nA; cB = nB; ++ui;
        if (wr == 1) PG8_BAR;
    }
    PG8_WAIT_V(0);
    PG8_BAR;
#undef PG8_SA
#undef PG8_SB
#undef PG8_STAGE
#undef PG8_LDA
#undef PG8_LDB
#undef PG8_MMA
#undef PG8_WAIT_V
#undef PG8_WAIT_L
#undef PG8_BAR
#undef PG8_SCHED
}
}

struct Args { const float* in[36]; float* out; unsigned char* ws; int ph_lo, ph_hi; };

struct Frame {
    const CAS Args* ap;
    LAS unsigned char* lds;
    int tid, lane, wave, vcu, G, gw, NGW;
    unsigned char* ws;
};

DI int tid_now(const int wv) { int t; asm volatile("v_mbcnt_lo_u32_b32 %0, -1, 0\n\tv_mbcnt_hi_u32_b32 %0, -1, %0" : "=v"(t)); return t + wv * 64; }
DI Frame make_frame(LAS unsigned char* lds, const int wv) {
    Frame F; { const CAS Args* ap = (const CAS Args*)__builtin_amdgcn_kernarg_segment_ptr(); asm volatile("" : "+s"(ap)); F.ap = ap; } int t; asm volatile("v_mbcnt_lo_u32_b32 %0, -1, 0\n\tv_mbcnt_hi_u32_b32 %0, -1, %0" : "=v"(t)); t += wv * 64; int bx = blockIdx.x; asm volatile("" : "+s"(bx)); int G = gridDim.x; asm volatile("" : "+s"(G));
    F.lds = lds; F.tid = t; F.lane = t & 63; F.wave = __builtin_amdgcn_readfirstlane(t >> 6);
    F.G = G; F.vcu = (G % 8 == 0) ? (bx % 8) * (G / 8) + bx / 8 : bx;
    F.gw = F.vcu * NWAVES + F.wave; F.NGW = G * NWAVES; F.ws = F.ap->ws;
    return F;
}
DI int w1_row(int n) { const int o = n >> 1; return 256 * (o >> 7) + 128 * (n & 1) + (o & 127); }
DI void transpose_item(const float* W, int K, int N, bf16_t* WT, int mode, LAS float* scr, int item, int lane) {
    const int nblk = N / 32, kb = item / nblk, nb = item % nblk, k0 = 64 * kb, n0 = 32 * nb;
    { const int rr = lane >> 3, c4 = lane & 7; f32x4 v[8];
#pragma unroll
      for (int i = 0; i < 8; ++i) v[i] = *(const f32x4*)(W + (size_t)(k0 + 8 * i + rr) * N + n0 + 4 * c4);
#pragma unroll
      for (int i = 0; i < 8; ++i) { LAS float* d = scr + (8 * i + rr) * 33 + 4 * c4; d[0] = v[i].x; d[1] = v[i].y; d[2] = v[i].z; d[3] = v[i].w; } }
    LDS_WAIT(); asm volatile("" ::: "memory");
    const int c = lane & 7;
#pragma unroll
    for (int j = 0; j < 4; ++j) { const int n = (lane >> 3) + 8 * j; const LAS float* s = scr + (8 * c) * 33 + n;
        const int row = (mode & 1) ? w1_row(n0 + n) : (n0 + n);
        if (mode & 2) { u32x2 o; o.x = pk_fp8x4(s[0 * 33] * W8_SCALE, s[1 * 33] * W8_SCALE, s[2 * 33] * W8_SCALE, s[3 * 33] * W8_SCALE); o.y = pk_fp8x4(s[4 * 33] * W8_SCALE, s[5 * 33] * W8_SCALE, s[6 * 33] * W8_SCALE, s[7 * 33] * W8_SCALE);
            *(u32x2*)((unsigned char*)WT + (size_t)row * K + k0 + 8 * c) = o; }
        else { u32x4 o; o.x = pk2(s[0 * 33], s[1 * 33]); o.y = pk2(s[2 * 33], s[3 * 33]); o.z = pk2(s[4 * 33], s[5 * 33]); o.w = pk2(s[6 * 33], s[7 * 33]);
            *(u32x4*)(WT + (size_t)row * K + k0 + 8 * c) = o; } }
    LDS_WAIT(); asm volatile("" ::: "memory");
}

DI void phase_expert_weights(const Frame& F, int l, int which) {
    LAS float* scr = (LAS float*)(F.lds + F.wave * 16384);
    unsigned char* ws = F.ws;
    if (which == 0) {
        constexpr int IPM = (D / 64) * (2048 / 32);
        for (int it = F.gw; it < NE * IPM; it += F.NGW) { const int mtx = l * NE + it / IPM, r = it % IPM;
            transpose_item(F.ap->in[32] + (size_t)mtx * D * 2048, D, 2048, (bf16_t*)(ws + WS_W1 + (size_t)mtx * 2048 * D), 3, scr, r, F.lane); }
    }
    else {
        constexpr int IPM = (FF / 64) * (D / 32);
        for (int it = F.gw; it < NE * IPM; it += F.NGW) { const int mtx = l * NE + it / IPM, r = it % IPM;
            transpose_item(F.ap->in[34] + (size_t)mtx * FF * D, FF, D, (bf16_t*)(ws + WS_W2 + (size_t)mtx * D * FF), 2, scr, r, F.lane); }
    }
}
DI void phase_prologue(const Frame& F) {
    LAS float* scr = (LAS float*)(F.lds + F.wave * 16384);
    unsigned char* ws = F.ws;
    {
        constexpr int IPM = (D / 64) * (AB_PROJ / 32);
        for (int it = F.gw; it < 2 * IPM; it += F.NGW) { const int mtx = it / IPM, r = it % IPM;
            transpose_item(F.ap->in[8] + (size_t)mtx * D * AB_PROJ, D, AB_PROJ, (bf16_t*)(ws + WS_WIN + (size_t)mtx * AB_PROJ * D), 2, scr, r, F.lane); }
    }
    {
        constexpr int IPM = (D / 64) * (D / 32);
        for (int it = F.gw; it < 2 * IPM; it += F.NGW) { const int mtx = it / IPM, r = it % IPM;
            transpose_item(F.ap->in[25] + (size_t)mtx * D * D, D, D, (bf16_t*)(ws + WS_WOUT + (size_t)mtx * D * D), 2, scr, r, F.lane); }
    }
    {
        constexpr int IPM = (D / 64) * (QKV_N / 32);
        for (int it = F.gw; it < 2 * IPM; it += F.NGW) { const int mtx = it / IPM, r = it % IPM;
            transpose_item(F.ap->in[26] + (size_t)mtx * D * QKV_N, D, QKV_N, (bf16_t*)(ws + WS_WQKV + (size_t)mtx * QKV_N * D), 2, scr, r, F.lane); }
    }
    {
        constexpr int IPM = (D / 64) * (D / 32);
        for (int it = F.gw; it < 2 * IPM; it += F.NGW) { const int mtx = it / IPM, r = it % IPM;
            transpose_item(F.ap->in[28] + (size_t)mtx * D * D, D, D, (bf16_t*)(ws + WS_WO + (size_t)mtx * D * D), 2, scr, r, F.lane); }
    }
    const int gt = F.vcu * NTHR + F.tid, NGT = F.G * NTHR;
    for (int i = gt; i < 2 * LORA_N * LORA_K; i += NGT) {
        const int j = i / (LORA_N * LORA_K), r = i % (LORA_N * LORA_K), n = r / LORA_K, k = r % LORA_K; float v = 0.f;
        if (n < 1024) { if (k < 64) v = F.ap->in[12][(((size_t)j * 2 + (n >> 9)) * 64 + k) * 512 + (n & 511)]; }
        else if (n < 2048) { if (k >= 64 && k < 128) v = F.ap->in[14][(((size_t)j * 2 + ((n - 1024) >> 9)) * 64 + (k - 64)) * 512 + (n & 511)]; }
        else { if (k >= 128) v = F.ap->in[20][((size_t)j * 128 + (k - 128)) * 512 + (n - 2048)]; }
        ((bf16_t*)(ws + WS_WLORA))[i] = (bf16_t)f2bf(v);
    }
    for (int i = gt; i < 4 * 32 * D; i += NGT) { const int l = i / (32 * D), r = i % (32 * D), e = r / D, d = r % D;
        ((float*)(ws + WS_RWT))[i] = F.ap->in[30][((size_t)l * D + d) * 32 + e]; }
    for (int i = gt; i < 128 * 2048; i += NGT) { const int mtx = i >> 11, n = i & 2047; ((float*)(ws + WS_B1P))[(size_t)mtx * 2048 + w1_row(n)] = F.ap->in[33][i]; }
    __syncthreads();
    LAS float* ca = (LAS float*)F.lds;
    LAS float* red = (LAS float*)(F.lds + 32768);
    for (int i = F.tid; i < NB * D; i += NTHR) { const float c = F.ap->in[1][i]; ca[i] = c / (1.f + __expf(-c)); }
    __syncthreads();
    for (int u = F.vcu; u < 4 * 96; u += F.G) {
        const int l = u / 96, nb = u % 96, kq = F.wave, n = nb * 64 + F.lane;
        float acc[8];
#pragma unroll
        for (int b = 0; b < 8; ++b) acc[b] = 0.f;
        const float* wp = F.ap->in[2] + ((size_t)l * D + kq * 128) * 6144 + n;
#pragma unroll 4
        for (int k = 0; k < 128; ++k) { const float wv = wp[(size_t)k * 6144];
#pragma unroll
            for (int b = 0; b < 8; ++b) acc[b] += ca[b * D + kq * 128 + k] * wv; }
#pragma unroll
        for (int b = 0; b < 8; ++b) red[(kq * 8 + b) * 64 + F.lane] = acc[b];
        __syncthreads();
        { const int b = F.wave; float s = F.ap->in[3][(size_t)l * 6144 + n];
#pragma unroll
          for (int q = 0; q < 8; ++q) s += red[(q * 8 + b) * 64 + F.lane];
          ((float*)(ws + WS_MOD))[((size_t)l * NB + b) * 6144 + n] = s; }
        __syncthreads();
    }
}

DI float rms_rstd(const f32x4 (&v)[4]) {
    float s = 0.f;
#pragma unroll
    for (int j = 0; j < 4; ++j) s += (v[j].x * v[j].x + v[j].y * v[j].y) + (v[j].z * v[j].z + v[j].w * v[j].w);
    return __builtin_amdgcn_rsqf(wave_sum(s) * (1.f / D) + kf(1e-6f));
}
DI int rcol(int lane, int j) { return 8 * lane + 512 * (j >> 1) + 4 * (j & 1); }
DI void load_bf16_row(const bf16_t* row, int lane, f32x4 (&v)[4]) {
#pragma unroll
    for (int g = 0; g < 2; ++g) { const u32x4 w = *(const u32x4*)(row + 8 * lane + 512 * g);
        v[2 * g] = (f32x4){bf2f(w.x & 0xffffu), bf2f(w.x >> 16), bf2f(w.y & 0xffffu), bf2f(w.y >> 16)}; v[2 * g + 1] = (f32x4){bf2f(w.z & 0xffffu), bf2f(w.z >> 16), bf2f(w.w & 0xffffu), bf2f(w.w >> 16)}; }
}

DI void load_vec(const float* p, int lane, f32x4 (&v)[4]) {
#pragma unroll
    for (int j = 0; j < 4; ++j) v[j] = *(const f32x4*)(p + rcol(lane, j));
}
DI void mod_norm_row8(const f32x4 (&x)[4], const f32x4 (&A)[4], const f32x4 (&S)[4], unsigned char* orow, int lane) {
    const float rstd = rms_rstd(x);
#pragma unroll
    for (int g = 0; g < 2; ++g) { const f32x4 h0 = x[2 * g] * rstd * A[2 * g] + S[2 * g], h1 = x[2 * g + 1] * rstd * A[2 * g + 1] + S[2 * g + 1];
        u32x2 w; w.x = pk_fp8x4(h0.x, h0.y, h0.z, h0.w); w.y = pk_fp8x4(h1.x, h1.y, h1.z, h1.w); *(u32x2*)(orow + 8 * lane + 512 * g) = w; }
}
DI void store_bf16_row(bf16_t* row, int lane, const f32x4 (&v)[4]) {
#pragma unroll
    for (int g = 0; g < 2; ++g) { u32x4 w; w.x = pk2(v[2 * g].x, v[2 * g].y); w.y = pk2(v[2 * g].z, v[2 * g].w); w.z = pk2(v[2 * g + 1].x, v[2 * g + 1].y); w.w = pk2(v[2 * g + 1].z, v[2 * g + 1].w);
        *(u32x4*)(row + 8 * lane + 512 * g) = w; }
}
DI void phase_t0(const Frame& F) {
    const float* MOD = (const float*)(F.ws + WS_MOD);
    for (int blk = F.gw; blk < T / 16; blk += F.NGW) {
        const int t0 = blk * 16, b = t0 / SEQ; const float* m = MOD + ((size_t)0 * NB + b) * 6144;
        f32x4 A[4], S[4], g[4], sc[4]; load_vec(F.ap->in[4], F.lane, g); load_vec(m + 1 * D, F.lane, sc); load_vec(m, F.lane, S);
#pragma unroll
        for (int j = 0; j < 4; ++j) A[j] = g[j] * (sc[j] + 1.f);
#pragma unroll 2
        for (int q = 0; q < 16; ++q) { const int t = t0 + q; f32x4 x[4], hv[4];
            load_vec(F.ap->in[0] + (size_t)t * D, F.lane, x);
            store_bf16_row((bf16_t*)(F.ws + WS_XB) + (size_t)t * D, F.lane, x);
            mod_norm_row8(x, A, S, (unsigned char*)(F.ws + WS_H8) + (size_t)t * D, F.lane); }
    }
}

constexpr int HT_STRIDE = 1032, TL_PZ = 66560;
DI void phase_tail(const Frame& F, int l) {
    const float* MOD = (const float*)(F.ws + WS_MOD);
    LAS bf16_t* Ht = (LAS bf16_t*)F.lds;
    LAS float* Pz = (LAS float*)(F.lds + TL_PZ);
    LAS unsigned* hist = (LAS unsigned*)(F.lds + L_HIST);
    LAS unsigned* basew = (LAS unsigned*)(F.lds + L_BASE);
    const int r = F.lane & 31, h = F.lane >> 5;
    bf16x8 RWf[8];
    { const float* rw = (const float*)(F.ws + WS_RWT) + ((size_t)l * 32 + r) * D + 128 * F.wave + 8 * h;
#pragma unroll
      for (int s = 0; s < 8; ++s) { const f32x4 a = *(const f32x4*)(rw + 16 * s), b = *(const f32x4*)(rw + 16 * s + 4);
          u32x4 p; p.x = pk2(a.x, a.y); p.y = pk2(a.z, a.w); p.z = pk2(b.x, b.y); p.w = pk2(b.z, b.w); RWf[s] = __builtin_bit_cast(bf16x8, p); } }
    if (F.tid < 32) hist[F.tid] = 0u;
    __syncthreads();
    int* tok_e = (int*)(F.ws + WS_TOKE); int* tok_p = (int*)(F.ws + WS_TOKP); float* tok_g = (float*)(F.ws + WS_TOKG);
    const float rb = F.ap->in[31][l * 32 + r]; const float neg_big = kf(-3.0e38f);
    for (int ti = F.vcu; ti < T / 32; ti += F.G) {
        f32x4 Bv[4], Av[4], Sv[4];
        { const int b = (32 * ti) / SEQ; const float* m = MOD + ((size_t)l * NB + b) * 6144; f32x4 g[4], c[4];
          load_vec(F.ap->in[5] + (size_t)l * D, F.lane, g); load_vec(m + 2 * D, F.lane, c);
#pragma unroll
          for (int j = 0; j < 4; ++j) Bv[j] = g[j] * c[j];
          load_vec(F.ap->in[6] + (size_t)l * D, F.lane, g); load_vec(m + 4 * D, F.lane, c); load_vec(m + 3 * D, F.lane, Sv);
#pragma unroll
          for (int j = 0; j < 4; ++j) Av[j] = g[j] * (c[j] + 1.f); }
#pragma unroll 2
        for (int q = 0; q < 4; ++q) {
            const int tkl = 4 * F.wave + q, t = 32 * ti + tkl;
            f32x4 y[4], x[4], hv[4];
            load_bf16_row((const bf16_t*)(F.ws + WS_Y) + (size_t)t * D, F.lane, y);
            load_bf16_row((const bf16_t*)(F.ws + WS_XB) + (size_t)t * D, F.lane, x);
            const float rstd = rms_rstd(y);
#pragma unroll
            for (int j = 0; j < 4; ++j) x[j] = x[j] + Bv[j] * (y[j] * rstd);
            store_bf16_row((bf16_t*)(F.ws + WS_XB) + (size_t)t * D, F.lane, x);
            { const float rs2 = rms_rstd(x);
#pragma unroll
              for (int j = 0; j < 4; ++j) hv[j] = x[j] * rs2 * Av[j] + Sv[j];
#pragma unroll
              for (int g = 0; g < 2; ++g) { u32x2 w; w.x = pk_fp8x4(hv[2 * g].x, hv[2 * g].y, hv[2 * g].z, hv[2 * g].w); w.y = pk_fp8x4(hv[2 * g + 1].x, hv[2 * g + 1].y, hv[2 * g + 1].z, hv[2 * g + 1].w);
                  *(u32x2*)((unsigned char*)(F.ws + WS_H8) + (size_t)t * D + 8 * F.lane + 512 * g) = w; } }
#pragma unroll
            for (int g = 0; g < 2; ++g) { u32x4 w; w.x = pk2(hv[2 * g].x, hv[2 * g].y); w.y = pk2(hv[2 * g].z, hv[2 * g].w); w.z = pk2(hv[2 * g + 1].x, hv[2 * g + 1].y); w.w = pk2(hv[2 * g + 1].z, hv[2 * g + 1].w);
                *(LAS u32x4*)(Ht + tkl * HT_STRIDE + 8 * F.lane + 512 * g) = w; }
        }
        __syncthreads();
        { f32x16 acc;
#pragma unroll
          for (int i = 0; i < 16; ++i) acc[i] = 0.f;
#pragma unroll
          for (int s = 0; s < 8; ++s) { const bf16x8 af = *(const LAS bf16x8*)(Ht + r * HT_STRIDE + 128 * F.wave + 16 * s + 8 * h);
              acc = __builtin_amdgcn_mfma_f32_32x32x16_bf16(af, RWf[s], acc, 0, 0, 0); }
#pragma unroll
          for (int i = 0; i < 16; ++i) Pz[(F.wave * 32 + ((i & 3) + 8 * (i >> 2) + 4 * h)) * 32 + r] = acc[i]; }
        __syncthreads();
#pragma unroll 1
        for (int it = 0; it < 2; ++it) {
            const int tkl = 4 * F.wave + 2 * it + h, t = 32 * ti + tkl;
            float mylogit = rb;
#pragma unroll
            for (int w = 0; w < 8; ++w) mylogit += Pz[(w * 32 + tkl) * 32 + r];
            float tv[4]; int tix[4];
#pragma unroll
            for (int k = 0; k < 4; ++k) { float v = mylogit; int idx = r;
#pragma unroll
                for (int st = 0; st < 5; ++st) { float ov; int oi;
                    if (st == 0) { ov = __builtin_bit_cast(float, __builtin_amdgcn_update_dpp(0, __builtin_bit_cast(int, v), 0xB1, 0xf, 0xf, true)); oi = __builtin_amdgcn_update_dpp(0, idx, 0xB1, 0xf, 0xf, true); }
                    else if (st == 1) { ov = __builtin_bit_cast(float, __builtin_amdgcn_update_dpp(0, __builtin_bit_cast(int, v), 0x4E, 0xf, 0xf, true)); oi = __builtin_amdgcn_update_dpp(0, idx, 0x4E, 0xf, 0xf, true); }
                    else if (st == 2) { ov = __builtin_bit_cast(float, __builtin_amdgcn_update_dpp(0, __builtin_bit_cast(int, v), 0x141, 0xf, 0xf, true)); oi = __builtin_amdgcn_update_dpp(0, idx, 0x141, 0xf, 0xf, true); }
                    else if (st == 3) { ov = __builtin_bit_cast(float, __builtin_amdgcn_update_dpp(0, __builtin_bit_cast(int, v), 0x140, 0xf, 0xf, true)); oi = __builtin_amdgcn_update_dpp(0, idx, 0x140, 0xf, 0xf, true); }
                    else { ov = __builtin_bit_cast(float, shfl_src(__builtin_bit_cast(int, v), F.lane ^ 16)); oi = shfl_src(idx, F.lane ^ 16); }
                    if (ov > v || (ov == v && oi < idx)) { v = ov; idx = oi; } }
                tv[k] = v; tix[k] = idx; if (r == idx) mylogit = neg_big; }
            const float e1 = __expf(tv[1] - tv[0]), e2 = __expf(tv[2] - tv[0]), e3 = __expf(tv[3] - tv[0]); const float inv = __builtin_amdgcn_rcpf(1.f + e1 + e2 + e3);
            if (r < 4) { const int e = r == 0 ? tix[0] : r == 1 ? tix[1] : r == 2 ? tix[2] : tix[3];
                const float gk = (r == 0 ? 1.f : r == 1 ? e1 : r == 2 ? e2 : e3) * inv;
                const unsigned lp = atomicAdd((unsigned*)(hist + e), 1u);
                tok_e[(size_t)t * 4 + r] = e; tok_p[(size_t)t * 4 + r] = (int)lp; tok_g[(size_t)t * 4 + r] = gk; }
        }
    }
    __syncthreads();
    if (F.tid < 32) basew[F.tid] = __hip_atomic_fetch_add((unsigned*)(F.ws + WS_CTL) + CW_GCNT + l * 32 + F.tid, hist[F.tid], __ATOMIC_RELAXED, __HIP_MEMORY_SCOPE_AGENT);
    __syncthreads();
    for (int ti0 = F.vcu; ti0 < T / 32; ti0 += 4 * F.G) { const int ti = ti0 + (F.tid >> 7) * F.G;
        if (ti < T / 32) { const size_t i = (size_t)ti * 128 + (F.tid & 127); const int e = tok_e[i]; const int pos = tok_p[i] + (int)basew[e]; tok_p[i] = pos;
            ((int*)(F.ws + WS_SLOTTOK))[(size_t)e * pg8::CAPX + pos] = (int)(i >> 2); } }
}

DI void moe_tables(const Frame& F, int l) {
    LAS int* pstart = (LAS int*)(F.lds + L_PSTART); LAS int* ntl = (LAS int*)(F.lds + L_NTILES); LAS int* tile_e = (LAS int*)(F.lds + L_TILEE);
    __syncthreads();
    if (F.tid < 64) { const unsigned* gc = (const unsigned*)(F.ws + WS_CTL) + CW_GCNT + l * 32; const int e = F.lane;
        const int c = e < 32 ? (int)__hip_atomic_load(gc + e, __ATOMIC_RELAXED, __HIP_MEMORY_SCOPE_AGENT) : 0; const int tl = (c + 255) >> 8;
        int incl = tl;
#pragma unroll
        for (int o = 1; o < 32; o <<= 1) { const int v = shfl_src(incl, F.lane >= o ? F.lane - o : F.lane); if (F.lane >= o) incl += v; }
        const int st = incl - tl;
        if (e < 32) { pstart[e] = st * 256; ((LAS int*)(F.lds + L_CNT))[e] = c; }
        if (e == 31) { pstart[32] = incl * 256; ntl[0] = incl < MAX_TILES ? incl : MAX_TILES; }
#pragma clang loop unroll(disable) vectorize(disable)
        for (int i = 0; i < tl; ++i) if (st + i < MAX_TILES) tile_e[st + i] = e;
    }
    __syncthreads();
}


DI void phase_combine(const Frame& F, int l) {
    const LAS int* pstart = (const LAS int*)(F.lds + L_PSTART);
    const float* MOD = (const float*)(F.ws + WS_MOD);
    const int* tok_e = (const int*)(F.ws + WS_TOKE); const int* tok_p = (const int*)(F.ws + WS_TOKP); const float* tok_g = (const float*)(F.ws + WS_TOKG);
    const bool more = l + 1 < DEPTH; const float ysc = kf(1.f / 16.f);
    for (int blk = F.gw; blk < T / 16; blk += F.NGW) {
        const int t0 = blk * 16, b = t0 / SEQ; const float* m = MOD + ((size_t)l * NB + b) * 6144;
        f32x4 Bv[4], Av[4], Sv[4];
        { f32x4 g[4], c[4]; load_vec(F.ap->in[7] + (size_t)l * D, F.lane, g); load_vec(m + 5 * D, F.lane, c);
#pragma unroll
          for (int j = 0; j < 4; ++j) { Bv[j] = g[j] * c[j]; Av[j] = Bv[j]; Sv[j] = Bv[j]; }
          if (more) { const float* m2 = MOD + ((size_t)(l + 1) * NB + b) * 6144; load_vec(F.ap->in[4] + (size_t)(l + 1) * D, F.lane, g); load_vec(m2 + 1 * D, F.lane, c); load_vec(m2, F.lane, Sv);
#pragma unroll
              for (int j = 0; j < 4; ++j) Av[j] = g[j] * (c[j] + 1.f); } }
        const int ev = tok_e[(size_t)t0 * 4 + F.lane]; const int slotv = pstart[ev] + tok_p[(size_t)t0 * 4 + F.lane]; const int gvi = __builtin_bit_cast(int, tok_g[(size_t)t0 * 4 + F.lane]);
#pragma unroll 2
        for (int q = 0; q < 16; ++q) { const int t = t0 + q;
            f32x4 y[4], x[4], hv[4];
#pragma unroll
            for (int j = 0; j < 4; ++j) y[j] = (f32x4){0.f, 0.f, 0.f, 0.f};
            load_bf16_row((const bf16_t*)(F.ws + WS_XB) + (size_t)t * D, F.lane, x);
#pragma unroll
            for (int k = 0; k < 4; ++k) { const int slot = __builtin_amdgcn_readlane(slotv, 4 * q + k); const float gk = __builtin_bit_cast(float, __builtin_amdgcn_readlane(gvi, 4 * q + k)) * ysc;
                const unsigned char* rp = (const unsigned char*)(F.ws + WS_XS) + (size_t)slot * D + 8 * F.lane; unsigned w[4];
#pragma unroll
                for (int g = 0; g < 2; ++g) { const u32x2 ww = *(const u32x2*)(rp + 512 * g); w[2 * g] = ww.x; w[2 * g + 1] = ww.y; }
#pragma unroll
                for (int j = 0; j < 4; ++j) { const f32x2 lo = __builtin_amdgcn_cvt_pk_f32_fp8((int)w[j], false), hi = __builtin_amdgcn_cvt_pk_f32_fp8((int)w[j], true); y[j] += (f32x4){lo.x, lo.y, hi.x, hi.y} * gk; } }
            const float rstd = rms_rstd(y);
#pragma unroll
            for (int j = 0; j < 4; ++j) x[j] = x[j] + Bv[j] * (y[j] * rstd);
            if (more) { store_bf16_row((bf16_t*)(F.ws + WS_XB) + (size_t)t * D, F.lane, x); mod_norm_row8(x, Av, Sv, (unsigned char*)(F.ws + WS_H8) + (size_t)t * D, F.lane); }
            else {
#pragma unroll
                for (int j = 0; j < 4; ++j) *(f32x4*)(F.ap->out + (size_t)t * D + rcol(F.lane, j)) = x[j]; }
        }
    }
}

DI void unpack8(const u32x4 w, float (&o)[8]) { o[0] = bf2f(w.x & 0xffffu); o[1] = bf2f(w.x >> 16); o[2] = bf2f(w.y & 0xffffu); o[3] = bf2f(w.y >> 16); o[4] = bf2f(w.z & 0xffffu); o[5] = bf2f(w.z >> 16); o[6] = bf2f(w.w & 0xffffu); o[7] = bf2f(w.w >> 16); }
DI void load8f(const float* p, float (&o)[8]) { const f32x4 a = *(const f32x4*)p, b = *(const f32x4*)(p + 4); o[0] = a.x; o[1] = a.y; o[2] = a.z; o[3] = a.w; o[4] = b.x; o[5] = b.y; o[6] = b.z; o[7] = b.w; }
DI void store8f(float* p, const float (&o)[8]) { *(f32x4*)p = (f32x4){o[0], o[1], o[2], o[3]}; *(f32x4*)(p + 4) = (f32x4){o[4], o[5], o[6], o[7]}; }
DI void phase_e3a(const Frame& F, int j) {
    const bf16_t* P = (const bf16_t*)(F.ws + WS_P);
    const float* mup = F.ap->in[9] + (size_t)j * A_PROJ; const float* mun = F.ap->in[10] + (size_t)j * A_PROJ;
    const f32x4 mp = *(const f32x4*)(mup + 1536 + 4 * F.lane), mn = *(const f32x4*)(mun + 1536 + 4 * F.lane);
#pragma unroll 2
    for (int t = F.gw; t < T; t += F.NGW) {
        const int tt = t & (SEQ - 1); const int col = 1536 + 4 * F.lane;
        const u32x2 pc = *(const u32x2*)(P + (size_t)t * AB_PROJ + col);
        u32x2 pp = (u32x2){0u, 0u}, pn = (u32x2){0u, 0u};
        if (tt > 0) pp = *(const u32x2*)(P + (size_t)(t - 1) * AB_PROJ + col);
        if (tt < SEQ - 1) pn = *(const u32x2*)(P + (size_t)(t + 1) * AB_PROJ + col);
        const f32x4 c = (f32x4){bf2f(pc.x & 0xffffu), bf2f(pc.x >> 16), bf2f(pc.y & 0xffffu), bf2f(pc.y >> 16)};
        const f32x4 pv = (f32x4){bf2f(pp.x & 0xffffu), bf2f(pp.x >> 16), bf2f(pp.y & 0xffffu), bf2f(pp.y >> 16)};
        const f32x4 nv = (f32x4){bf2f(pn.x & 0xffffu), bf2f(pn.x >> 16), bf2f(pn.y & 0xffffu), bf2f(pn.y >> 16)};
        f32x4 s = c + mp * (pv - c) + mn * (nv - c);
        if (F.lane < 16) { s.x = tanhf_(s.x); s.y = tanhf_(s.y); s.z = tanhf_(s.z); s.w = tanhf_(s.w); }
        else if (F.lane >= 32) { s.x = sigmoidf_(s.x); s.y = sigmoidf_(s.y); s.z = sigmoidf_(s.z); s.w = sigmoidf_(s.w); }
        u32x2 w; w.x = pk2(s.x, s.y); w.y = pk2(s.z, s.w);
        *(u32x2*)((bf16_t*)(F.ws + WS_LIN) + (size_t)t * LORA_K + 4 * F.lane) = w;
    }
    LAS float* hc = (LAS float*)F.lds;
    const float* cw = F.ap->in[21] + (size_t)j * 31 * 512; const float* cb = F.ap->in[22] + (size_t)j * 512;
    const float* gg = F.ap->in[23] + (size_t)j * 512; const float* gb = F.ap->in[24] + (size_t)j * 512;
    unsigned char* YAB = (unsigned char*)(F.ws + WS_YAB); const float eps5 = kf(1e-5f);
    for (int u = F.vcu; u < NB * 32 * 8; u += F.G) {
        const int g = u & 7, tile = (u >> 3) & 31, b = u >> 8; const int t0 = tile * 128, ch = g * 64 + F.lane;
        __syncthreads();
        {
            u32x4 uu[3], gv[3]; bool ok[3];
#pragma unroll
            for (int it = 0; it < 3; ++it) { const int cidx = F.tid + it * NTHR, r = cidx >> 3, part = cidx & 7, tt = t0 - 15 + r; ok[it] = cidx < 158 * 8 && tt >= 0 && tt < SEQ;
                uu[it] = (u32x4){0u, 0u, 0u, 0u}; gv[it] = (u32x4){0u, 0u, 0u, 0u};
                if (ok[it]) { const bf16_t* pr = P + (size_t)(b * SEQ + tt) * AB_PROJ + A_PROJ + g * 64 + part * 8; uu[it] = *(const u32x4*)pr; gv[it] = *(const u32x4*)(pr + 512); } }
#pragma unroll
            for (int it = 0; it < 3; ++it) { const int cidx = F.tid + it * NTHR;
                if (cidx < 158 * 8) { float a[8], gt[8], o[8]; unpack8(uu[it], a); unpack8(gv[it], gt);
#pragma unroll
                    for (int i = 0; i < 8; ++i) o[i] = ok[it] ? a[i] * sigmoidf_(gt[i]) : 0.f;
                    LAS f32x4* dst = (LAS f32x4*)(hc + cidx * 8); dst[0] = (f32x4){o[0], o[1], o[2], o[3]}; dst[1] = (f32x4){o[4], o[5], o[6], o[7]}; } }
        }
        __syncthreads();
        float w[31];
#pragma unroll
        for (int q = 0; q < 31; ++q) w[q] = cw[q * 512 + ch];
        const float bias = cb[ch], gng = gg[ch], gnb = gb[ch];
        float x[46];
#pragma unroll
        for (int q = 0; q < 46; ++q) x[q] = hc[(F.wave * 16 + q) * 64 + F.lane];
#pragma unroll
        for (int i = 0; i < 16; ++i) { float acc = bias;
#pragma unroll
            for (int q = 0; q < 31; ++q) acc += x[i + q] * w[q];
            const float mean = wave_sum(acc) * (1.f / 64.f); const float dlt = acc - mean; const float var = wave_sum(dlt * dlt) * (1.f / 64.f);
            const float yv = dlt * __builtin_amdgcn_rsqf(var + eps5) * gng + gnb; const float o = yv * sigmoidf_(yv);
            YAB[(size_t)(b * SEQ + t0 + F.wave * 16 + i) * D + 512 + ch] = (unsigned char)(pk_fp8x4(o, 0.f, 0.f, 0.f) & 0xffu); }
    }
}

DI float red8(float x) {
    x += __builtin_bit_cast(float, __builtin_amdgcn_update_dpp(0, __builtin_bit_cast(int, x), 0xB1, 0xf, 0xf, true));
    x += __builtin_bit_cast(float, __builtin_amdgcn_update_dpp(0, __builtin_bit_cast(int, x), 0x4E, 0xf, 0xf, true));
    x = DPP_ADD(x, 0x141);
    return x;
}
DI float quad_sum(float x) {
    x += __builtin_bit_cast(float, __builtin_amdgcn_update_dpp(0, __builtin_bit_cast(int, x), 0xB1, 0xf, 0xf, true));
    x += __builtin_bit_cast(float, __builtin_amdgcn_update_dpp(0, __builtin_bit_cast(int, x), 0x4E, 0xf, 0xf, true));
    return x;
}

typedef __bf16 bfv2 __attribute__((ext_vector_type(2)));
DI unsigned cvt2(float lo, float hi) { return __builtin_bit_cast(unsigned, __builtin_convertvector((f32x2){lo, hi}, bfv2)); }
constexpr int NSUB = 256;
constexpr size_t C_TH = 2976 * MiB, C_KH = 3232 * MiB, C_RH = 3296 * MiB, C_WH = 3360 * MiB, C_VT = 3376 * MiB, C_Y = 3440 * MiB;
constexpr int G_STR = 72;
constexpr int SL_G1 = 0, SL_C1T = 0, SL_MS = 2560, SL_NK = 3072, SL_WBT = 3584, SL_G2 = 4608, SL_NB = 4608, SL_WKT = 5632, SL_G2R = 4608 + 16 * G_STR * 2, SL_AT = 9216, SL_BT = 11264, SL_KT = 13312, SL_PL = 15360;
DI void sub_tail(const Frame& F, LAS unsigned char* wl, const size_t u, const float (&at)[16], const float (&bt)[16], const float (&kt)[16], const float (&rt)[16], const float (&vt)[16], const float p) {
    bf16_t* THT = (bf16_t*)(F.ws + C_TH); bf16_t* KHA = (bf16_t*)(F.ws + C_KH); bf16_t* RHT = (bf16_t*)(F.ws + C_RH); bf16_t* WHT = (bf16_t*)(F.ws + C_WH); bf16_t* VTG = (bf16_t*)(F.ws + C_VT);
    int ln = F.lane; asm volatile("" : "+v"(ln));
    const int k = ln, r = ln & 31, h = ln >> 5, c16 = ln & 15, q4 = ln >> 4;
        { LAS bf16_t* G1 = (LAS bf16_t*)(wl + SL_G1); LAS bf16_t* G2 = (LAS bf16_t*)(wl + SL_G2);
#pragma unroll
          for (int t = 0; t < 16; ++t) { const unsigned c0 = cvt2(bt[t], kt[t]), c1 = cvt2(at[t], rt[t]); G1[t * G_STR + k] = (bf16_t)(c0 & 0xffffu); G1[(16 + t) * G_STR + k] = (bf16_t)(c0 >> 16); G2[t * G_STR + k] = (bf16_t)(c1 & 0xffffu); G2[(16 + t) * G_STR + k] = (bf16_t)(c1 >> 16); }
          u32x4 w0, w1;
          w0 = (u32x4){cvt2(at[0], at[1]), cvt2(at[2], at[3]), cvt2(at[4], at[5]), cvt2(at[6], at[7])}; w1 = (u32x4){cvt2(at[8], at[9]), cvt2(at[10], at[11]), cvt2(at[12], at[13]), cvt2(at[14], at[15])};
          *(LAS u32x4*)(wl + SL_AT + k * 32) = w0; *(LAS u32x4*)(wl + SL_AT + k * 32 + 16) = w1;
          w0 = (u32x4){cvt2(bt[0], bt[1]), cvt2(bt[2], bt[3]), cvt2(bt[4], bt[5]), cvt2(bt[6], bt[7])}; w1 = (u32x4){cvt2(bt[8], bt[9]), cvt2(bt[10], bt[11]), cvt2(bt[12], bt[13]), cvt2(bt[14], bt[15])};
          *(LAS u32x4*)(wl + SL_BT + k * 32) = w0; *(LAS u32x4*)(wl + SL_BT + k * 32 + 16) = w1;
          w0 = (u32x4){cvt2(kt[0], kt[1]), cvt2(kt[2], kt[3]), cvt2(kt[4], kt[5]), cvt2(kt[6], kt[7])}; w1 = (u32x4){cvt2(kt[8], kt[9]), cvt2(kt[10], kt[11]), cvt2(kt[12], kt[13]), cvt2(kt[14], kt[15])};
          *(LAS u32x4*)(wl + SL_KT + k * 32) = w0; *(LAS u32x4*)(wl + SL_KT + k * 32 + 16) = w1;
          w0 = (u32x4){cvt2(vt[0], vt[1]), cvt2(vt[2], vt[3]), cvt2(vt[4], vt[5]), cvt2(vt[6], vt[7])}; w1 = (u32x4){cvt2(vt[8], vt[9]), cvt2(vt[10], vt[11]), cvt2(vt[12], vt[13]), cvt2(vt[14], vt[15])};
          u32x4* vg = (u32x4*)(VTG + (size_t)u * 1024 + k * 16); vg[0] = w0; vg[1] = w1;
          *(LAS float*)(wl + SL_PL + k * 4) = p; }
        f32x16 x;
#pragma unroll
        for (int i = 0; i < 16; ++i) x[i] = 0.f;
#pragma unroll
        for (int s = 0; s < 4; ++s) { const bf16x8 af = *(const LAS bf16x8*)(wl + SL_G1 + (r * G_STR + 16 * s + 8 * h) * 2), bf = *(const LAS bf16x8*)(wl + SL_G2 + (r * G_STR + 16 * s + 8 * h) * 2);
            x = __builtin_amdgcn_mfma_f32_32x32x16_bf16(af, bf, x, 0, 0, 0); }
        {
            float xv[16];
#pragma unroll
            for (int i = 0; i < 16; ++i) xv[i] = x[i];
            asm volatile("" ::: "memory");
#pragma unroll
            for (int i = 0; i < 8; ++i) { const int m = (i & 3) + 8 * (i >> 2) + 4 * h;
                if (r < 16) *(LAS float*)(wl + SL_NB + (m * 16 + r) * 4) = (m < r) ? xv[i] : 0.f;
                else *(LAS bf16_t*)(wl + SL_WBT + ((r - 16) * 16 + m) * 2) = (bf16_t)f2bf((m <= r - 16) ? xv[i] : 0.f); }
#pragma unroll
            for (int i = 8; i < 16; ++i) { const int m = (i & 3) + 8 * ((i >> 2) - 2) + 4 * h;
                if (r < 16) *(LAS bf16_t*)(wl + SL_NK + (m * 16 + r) * 2) = (bf16_t)f2bf((m < r) ? xv[i] : 0.f);
                else *(LAS float*)(wl + SL_WKT + ((r - 16) * 16 + m) * 4) = (m <= r - 16) ? xv[i] : 0.f; }
        }
        {   float M[16];
#pragma unroll
            for (int s = 15; s >= 0; --s) { float acc = 0.f;
#pragma unroll
                for (int uu = s + 1; uu < 16; ++uu) acc += *(const LAS float*)(wl + SL_NB + (s * 16 + uu) * 4) * M[uu];
                M[s] = (s == c16) ? 1.f : ((s > c16) ? 0.f : acc); }
            if (ln < 16) {
#pragma unroll
                for (int s = 0; s < 16; ++s) *(LAS bf16_t*)(wl + SL_MS + (s * 16 + c16) * 2) = (bf16_t)f2bf(M[s]); }
        }
        {   const s16x4 a1 = *(const LAS s16x4*)(wl + SL_MS + (c16 * 16 + 4 * q4) * 2);
#pragma unroll
            for (int nt = 0; nt < 5; ++nt) { const s16x4 b1 = nt == 0 ? *(const LAS s16x4*)(wl + SL_WBT + (c16 * 16 + 4 * q4) * 2) : *(const LAS s16x4*)(wl + SL_BT + ((16 * (nt - 1) + c16) * 16 + 4 * q4) * 2);
                f32x4 c = (f32x4){0.f, 0.f, 0.f, 0.f}; c = __builtin_amdgcn_mfma_f32_16x16x16bf16_1k(a1, b1, c, 0, 0, 0);
                u32x2 w; w.x = cvt2(c[0], c[1]); w.y = cvt2(c[2], c[3]); *(LAS u32x2*)(wl + SL_C1T + ((16 * nt + c16) * 16 + 4 * q4) * 2) = w; }
        }
        {   s16x4 b2[5];
#pragma unroll
            for (int nt = 0; nt < 5; ++nt) b2[nt] = *(const LAS s16x4*)(wl + SL_C1T + ((16 * nt + c16) * 16 + 4 * q4) * 2);
            float pl[4];
#pragma unroll
            for (int nt = 1; nt < 5; ++nt) pl[nt - 1] = *(const LAS float*)(wl + SL_PL + (16 * (nt - 1) + c16) * 4);
#pragma unroll
            for (int mt = 0; mt < 5; ++mt) { const s16x4 a2 = mt < 4 ? *(const LAS s16x4*)(wl + SL_AT + ((16 * mt + c16) * 16 + 4 * q4) * 2) : *(const LAS s16x4*)(wl + SL_NK + (c16 * 16 + 4 * q4) * 2);
#pragma unroll
                for (int nt = 0; nt < 5; ++nt) { f32x4 c = (f32x4){0.f, 0.f, 0.f, 0.f}; c = __builtin_amdgcn_mfma_f32_16x16x16bf16_1k(a2, b2[nt], c, 0, 0, 0);
                    const int r0 = 4 * q4;
                    if (mt < 4 && nt == 0) { const u32x2 g = *(const LAS u32x2*)(wl + SL_G2R + (c16 * G_STR + 16 * mt + r0) * 2);
                        u32x2 w; w.x = cvt2(c[0] + bf2f(g.x & 0xffffu), c[1] + bf2f(g.x >> 16)); w.y = cvt2(c[2] + bf2f(g.y & 0xffffu), c[3] + bf2f(g.y >> 16));
                        *(u32x2*)(RHT + (size_t)u * 1024 + c16 * 64 + 4 * ((4 * mt + q4) ^ c16)) = w; }
                    else if (mt < 4) { const int kp = 16 * (nt - 1) + c16, k0 = 16 * mt + r0; const float s = pl[nt - 1];
                        u32x2 w; w.x = cvt2((c[0] + (k0 == kp ? 1.f : 0.f)) * s, (c[1] + (k0 + 1 == kp ? 1.f : 0.f)) * s); w.y = cvt2((c[2] + (k0 + 2 == kp ? 1.f : 0.f)) * s, (c[3] + (k0 + 3 == kp ? 1.f : 0.f)) * s);
                        *(u32x2*)(THT + (size_t)u * 4096 + kp * 64 + 4 * ((4 * mt + q4) ^ c16)) = w; }
                    else if (nt == 0) { const f32x4 wk = *(const LAS f32x4*)(wl + SL_WKT + (c16 * 16 + r0) * 4);
                        u32x2 w; w.x = cvt2(c[0] + wk[0], c[1] + wk[1]); w.y = cvt2(c[2] + wk[2], c[3] + wk[3]);
                        *(u32x2*)(WHT + (size_t)u * 256 + c16 * 16 + r0) = w; }
                    else { const int kp = 16 * (nt - 1) + c16; const float s = pl[nt - 1]; const u32x2 g = *(const LAS u32x2*)(wl + SL_KT + (kp * 16 + r0) * 2);
                        u32x2 w; w.x = cvt2((c[0] + bf2f(g.x & 0xffffu)) * s, (c[1] + bf2f(g.x >> 16)) * s); w.y = cvt2((c[2] + bf2f(g.y & 0xffffu)) * s, (c[3] + bf2f(g.y >> 16)) * s);
                        *(u32x2*)(KHA + (size_t)u * 1024 + kp * 16 + r0) = w; }
                }
            }
        }
    asm volatile("s_waitcnt lgkmcnt(0)" ::: "memory");
}
DI float softplus_(float x) { return fmaxf(x, 0.f) + __logf(1.f + __expf(-fabsf(x))); }
DI void phase_rsub(const Frame& F, int j) {
    const bf16_t* P = (const bf16_t*)(F.ws + WS_P); const bf16_t* LO = (const bf16_t*)(F.ws + WS_LO);
    float* BS = (float*)(F.ws + WS_BS);
    LAS unsigned char* wl = F.lds + F.wave * 16384;
    const int k = F.lane; const float dk = kf(-0.60653066f);
    for (int u = F.gw; u < NB * NSUB * RH; u += F.NGW) {
        const int hd = u & 7, jj = (u >> 3) & (NSUB - 1), b = u >> 11, ch = hd * 64 + k, tt0 = 16 * jj;
        float mp[3], mn[3];
#pragma unroll
        for (int q = 0; q < 3; ++q) { mp[q] = F.ap->in[9][(size_t)j * A_PROJ + q * 512 + ch]; mn[q] = F.ap->in[10][(size_t)j * A_PROJ + q * 512 + ch]; }
        const float kkw = F.ap->in[15][j * 512 + ch], kaw = F.ap->in[16][j * 512 + ch], rkw = F.ap->in[17][j * 512 + ch];
        const float w00 = F.ap->in[11][(j * 2 + 0) * 512 + ch], w01 = F.ap->in[11][(j * 2 + 1) * 512 + ch], a00 = F.ap->in[13][(j * 2 + 0) * 512 + ch], a01 = F.ap->in[13][(j * 2 + 1) * 512 + ch];
        unsigned RA[16], VL[16], KB0[16], LK1[16], B1[16]; float bsv = 0.f;
        {   float r0[3], r1[3];
#pragma unroll
            for (int q = 0; q < 3; ++q) { const bf16_t* pr = P + (size_t)(b * SEQ + tt0) * AB_PROJ + ch + q * 512; r0[q] = tt0 > 0 ? bf2f(pr[-AB_PROJ]) : 0.f; r1[q] = bf2f(pr[0]); }
#pragma unroll
            for (int g4 = 0; g4 < 4; ++g4) {
                float nx[4][3], lov[4][4];
#pragma unroll
                for (int ii = 0; ii < 4; ++ii) { const int tt = tt0 + 4 * g4 + ii + 1; const bool ok = tt < SEQ; const bf16_t* pr = P + (size_t)(b * SEQ + (ok ? tt : tt0)) * AB_PROJ + ch;
#pragma unroll
                    for (int q = 0; q < 3; ++q) { const float v = bf2f(pr[q * 512]); nx[ii][q] = ok ? v : 0.f; }
                    const bf16_t* lo = LO + ((size_t)b * SEQ + tt0 + 4 * g4 + ii) * LORA_N + ch;
#pragma unroll
                    for (int q = 0; q < 4; ++q) lov[ii][q] = bf2f(lo[q * 512]); }
#pragma unroll
                for (int ii = 0; ii < 4; ++ii) { const int i = 4 * g4 + ii; float x[3];
#pragma unroll
                    for (int q = 0; q < 3; ++q) { const float c = r1[q]; x[q] = c + mp[q] * (r0[q] - c) + mn[q] * (nx[ii][q] - c); r0[q] = c; r1[q] = nx[ii][q]; }
                    const float wl0 = lov[ii][0], wl1 = lov[ii][1], al0 = lov[ii][2], al1 = lov[ii][3];
                    const float kk = x[1] * kkw; const float kkn = kk * __builtin_amdgcn_rsqf(fmaxf(wave_sum(kk * kk), 1e-24f));
                    const float lw0 = dk * sigmoidf_(w00 + wl0), lw1 = dk * sigmoidf_(w01 + wl1);
                    const float ad0 = sigmoidf_(a00 + al0), ad1 = sigmoidf_(a01 + al1);
                    const float kd0 = x[1] * (1.f + (ad0 - 1.f) * kaw), kd1 = x[1] * (1.f + (ad1 - 1.f) * kaw);
                    const float bs = wave_sum(x[0] * (kd0 + kd1) * rkw);
                    bsv = k == i ? bs : bsv;
                    RA[i] = cvt2(x[0], -kkn); VL[i] = cvt2(x[2], lw0); KB0[i] = cvt2(kd0, kkn * ad0); LK1[i] = cvt2(lw1, kd1); B1[i] = cvt2(kkn * ad1, 0.f); }
                asm volatile("" ::: "memory");
            }
            if (k < 16) BS[((size_t)b * SEQ + tt0 + k) * 8 + hd] = bsv; }
        {
            float at[16], bt[16], kt[16], rt[16], vt[16]; float p = 1.f, cum = 0.f;
#pragma unroll
            for (int t = 0; t < 16; ++t) { const float rv = bf2f(RA[t] & 0xffffu), av = bf2f(RA[t] >> 16), vv = bf2f(VL[t] & 0xffffu), lw = bf2f(VL[t] >> 16), kv = bf2f(KB0[t] & 0xffffu), bv = bf2f(KB0[t] >> 16);
                at[t] = p * av; cum += lw; p = __expf(cum); const float ip = __expf(-cum); bt[t] = bv * ip; kt[t] = kv * ip; rt[t] = p * rv; vt[t] = vv; }
            sub_tail(F, wl, (size_t)((b * 16 + hd * 2 + 0) * NSUB + jj), at, bt, kt, rt, vt, p); }
        {
            float at[16], bt[16], kt[16], rt[16], vt[16]; float p = 1.f, cum = 0.f;
#pragma unroll
            for (int t = 0; t < 16; ++t) { const int i = 15 - t; const float rv = bf2f(RA[i] & 0xffffu), av = bf2f(RA[i] >> 16), vv = bf2f(VL[i] & 0xffffu), lw = bf2f(LK1[i] & 0xffffu), kv = bf2f(LK1[i] >> 16), bv = bf2f(B1[i] & 0xffffu);
                at[t] = p * av; cum += lw; p = __expf(cum); const float ip = __expf(-cum); bt[t] = bv * ip; kt[t] = kv * ip; rt[t] = p * rv; vt[t] = vv; }
            sub_tail(F, wl, (size_t)((b * 16 + hd * 2 + 1) * NSUB + (NSUB - 1 - jj)), at, bt, kt, rt, vt, p); }
    }
}

constexpr int CH_NST = 6, CH_PF = 4, CH_STB = 14336, CH_YB = CH_NST * CH_STB;
DI void chain_issue(LAS unsigned char* st, const bf16_t* THT, const bf16_t* KHA, const bf16_t* RHT, const bf16_t* WHT, const bf16_t* VTG, size_t u, int rb, int lane) {
    const char* th = (const char*)(THT + u * 4096) + lane * 16;
#pragma unroll
    for (int i = 0; i < 8; ++i) __builtin_amdgcn_global_load_lds((const unsigned*)(th + i * 1024), (LAS unsigned*)(st + i * 1024), 16, 0, 0);
    const char* kh = (const char*)(KHA + u * 1024) + lane * 16;
    __builtin_amdgcn_global_load_lds((const unsigned*)kh, (LAS unsigned*)(st + 8192), 16, 0, 0); __builtin_amdgcn_global_load_lds((const unsigned*)(kh + 1024), (LAS unsigned*)(st + 9216), 16, 0, 0);
    const char* rh = (const char*)(RHT + u * 1024) + lane * 16;
    __builtin_amdgcn_global_load_lds((const unsigned*)rh, (LAS unsigned*)(st + 10240), 16, 0, 0); __builtin_amdgcn_global_load_lds((const unsigned*)(rh + 1024), (LAS unsigned*)(st + 11264), 16, 0, 0);
    const char* vt = (const char*)(VTG + u * 1024 + rb * 512);
    const char* gx = lane < 32 ? (const char*)(WHT + u * 256) + lane * 16 : vt + (lane - 32) * 16;
    const char* gy = vt + 512 + (lane & 31) * 16;
    __builtin_amdgcn_global_load_lds((const unsigned*)gx, (LAS unsigned*)(st + 12288), 16, 0, 0); __builtin_amdgcn_global_load_lds((const unsigned*)gy, (LAS unsigned*)(st + 13312), 16, 0, 0);
}
DI bf16x8 pack8(const f32x16& x, int s) {
    u32x4 p; p.x = cvt2(x[8 * s], x[8 * s + 1]); p.y = cvt2(x[8 * s + 2], x[8 * s + 3]); p.z = cvt2(x[8 * s + 4], x[8 * s + 5]); p.w = cvt2(x[8 * s + 6], x[8 * s + 7]);
    return __builtin_bit_cast(bf16x8, p);
}
DI bf16x8 cat8(const LAS unsigned char* p0, const LAS unsigned char* p1) { const s16x4 a = *(const LAS s16x4*)p0, b = *(const LAS s16x4*)p1; return __builtin_shufflevector(a, b, 0, 1, 2, 3, 4, 5, 6, 7); }
DI void phase_chain(const Frame& F) {
    const bf16_t* THT = (const bf16_t*)(F.ws + C_TH); const bf16_t* KHA = (const bf16_t*)(F.ws + C_KH); const bf16_t* RHT = (const bf16_t*)(F.ws + C_RH); const bf16_t* WHT = (const bf16_t*)(F.ws + C_WH); const bf16_t* VTG = (const bf16_t*)(F.ws + C_VT);
    bf16_t* YD = (bf16_t*)(F.ws + C_Y);
    const int r = F.lane & 31, h = F.lane >> 5, rs = r & 15;
    LAS unsigned char* ring = F.lds; LAS unsigned char* ybuf = F.lds + CH_YB;
    for (int task = F.vcu; task < NSEQ * 2; task += F.G) {
        const int seq = task >> 1, rb = task & 1, b = seq >> 4, hd = (seq >> 1) & 7, d = seq & 1;
        const size_t u0 = (size_t)seq * NSUB;
        if (F.wave >= 2) {
#pragma unroll 1
            for (int jj = 0; jj <= NSUB; ++jj) __builtin_amdgcn_s_barrier();
        } else if (F.wave == 1) {
#pragma unroll 1
            for (int s = 0; s < CH_PF; ++s) chain_issue(ring + s * CH_STB, THT, KHA, RHT, WHT, VTG, u0 + s, rb, F.lane);
            int nst = CH_PF;
#pragma unroll 1
            for (int jj = 0; jj < NSUB; ++jj) {
                const int jn = jj + CH_PF < NSUB ? jj + CH_PF : NSUB - 1;
                chain_issue(ring + nst * CH_STB, THT, KHA, RHT, WHT, VTG, u0 + jn, rb, F.lane);
                nst = nst == CH_NST - 1 ? 0 : nst + 1;
                asm volatile("s_waitcnt vmcnt(56)" ::: "memory");
                __builtin_amdgcn_s_barrier();
            }
            VM_WAIT();
            __builtin_amdgcn_s_barrier();
        } else {
            f32x16 S0, S1;
#pragma unroll
            for (int i = 0; i < 16; ++i) { S0[i] = 0.f; S1[i] = 0.f; }
            int cur = 0;
#pragma unroll 1
            for (int jj = 0; jj < NSUB; ++jj) {
                __builtin_amdgcn_s_barrier(); asm volatile("" ::: "memory");
                const LAS unsigned char* st = ring + cur * CH_STB;
                bf16x8 sb[4]; sb[0] = pack8(S0, 0); sb[1] = pack8(S0, 1); sb[2] = pack8(S1, 0); sb[3] = pack8(S1, 1);
                const bf16x8 vt = *(const LAS bf16x8*)(st + 12800 + r * 32 + h * 16), wh = *(const LAS bf16x8*)(st + 12288 + rs * 32 + h * 16);
                const bf16x8 kh0 = *(const LAS bf16x8*)(st + 8192 + r * 32 + h * 16), kh1 = *(const LAS bf16x8*)(st + 8192 + (32 + r) * 32 + h * 16);
                f32x16 Y, N0, N1;
#pragma unroll
                for (int i = 0; i < 16; ++i) { Y[i] = 0.f; N0[i] = 0.f; N1[i] = 0.f; }
                Y = __builtin_amdgcn_mfma_f32_32x32x16_bf16(wh, vt, Y, 0, 0, 0);
                N0 = __builtin_amdgcn_mfma_f32_32x32x16_bf16(kh0, vt, N0, 0, 0, 0);
                N1 = __builtin_amdgcn_mfma_f32_32x32x16_bf16(kh1, vt, N1, 0, 0, 0);
#pragma unroll
                for (int ks = 0; ks < 4; ++ks) { const int c0 = ((4 * ks + h) ^ rs) * 8, c1 = ((4 * ks + h + 2) ^ rs) * 8;
                    Y = __builtin_amdgcn_mfma_f32_32x32x16_bf16(cat8(st + 10240 + rs * 128 + c0, st + 10240 + rs * 128 + c1), sb[ks], Y, 0, 0, 0);
                    N0 = __builtin_amdgcn_mfma_f32_32x32x16_bf16(cat8(st + r * 128 + c0, st + r * 128 + c1), sb[ks], N0, 0, 0, 0);
                    N1 = __builtin_amdgcn_mfma_f32_32x32x16_bf16(cat8(st + (32 + r) * 128 + c0, st + (32 + r) * 128 + c1), sb[ks], N1, 0, 0, 0); }
                S0 = N0; S1 = N1;
#pragma unroll
                for (int q = 0; q < 8; q += 1) { const int t = (q & 3) + 8 * (q >> 2) + 4 * h; *(LAS bf16_t*)(ybuf + (t * 32 + r) * 2) = (bf16_t)(cvt2(Y[q], 0.f) & 0xffffu); }
                { const u32x4 w = *(const LAS u32x4*)(ybuf + F.lane * 16); const int t = F.lane >> 2, step = 16 * jj + t, tt = d ? (SEQ - 1 - step) : step;
                  *(u32x4*)(YD + ((size_t)d * T + (size_t)b * SEQ + tt) * 512 + hd * 64 + 32 * rb + 8 * (F.lane & 3)) = w; }
                cur = cur == CH_NST - 1 ? 0 : cur + 1;
            }
            VM_WAIT();
            asm volatile("s_waitcnt lgkmcnt(0)" ::: "memory");
            __builtin_amdgcn_s_barrier();
        }
    }
}

DI void phase_fin(const Frame& F, int j) {
    const bf16_t* YD = (const bf16_t*)(F.ws + C_Y); const float* BS = (const float*)(F.ws + WS_BS); const bf16_t* P = (const bf16_t*)(F.ws + WS_P); const bf16_t* LO = (const bf16_t*)(F.ws + WS_LO); unsigned char* YAB = (unsigned char*)(F.ws + WS_YAB);
    const int ch0 = F.lane * 8; const float eps64 = kf(64e-5f);
    float lg[8], lb[8]; load8f(F.ap->in[18] + j * 512 + ch0, lg); load8f(F.ap->in[19] + j * 512 + ch0, lb);
    float mp[8], mn[8]; load8f(F.ap->in[9] + (size_t)j * A_PROJ + 1024 + ch0, mp); load8f(F.ap->in[10] + (size_t)j * A_PROJ + 1024 + ch0, mn);
    for (int t = F.gw; t < T; t += F.NGW) {
        float yf[8], yb[8], bo[8], ga[8]; unpack8(*(const u32x4*)(YD + (size_t)t * 512 + ch0), yf); unpack8(*(const u32x4*)(YD + ((size_t)T + t) * 512 + ch0), yb); unpack8(*(const u32x4*)(LO + (size_t)t * LORA_N + 2048 + ch0), ga);
        {
            const int tt = t & (SEQ - 1); const bf16_t* pr = P + (size_t)t * AB_PROJ + 1024 + ch0; const float bs = BS[(size_t)t * 8 + (F.lane >> 3)];
            float c[8], pv[8], nv[8]; unpack8(*(const u32x4*)pr, c); unpack8(*(const u32x4*)(pr - (tt > 0 ? AB_PROJ : 0)), pv); unpack8(*(const u32x4*)(pr + (tt < SEQ - 1 ? AB_PROJ : 0)), nv);
#pragma unroll
            for (int i = 0; i < 8; ++i) { const float p0 = tt > 0 ? pv[i] : 0.f, n0 = tt < SEQ - 1 ? nv[i] : 0.f; bo[i] = bs * (c[i] + mp[i] * (p0 - c[i]) + mn[i] * (n0 - c[i])); } }
        float s = 0.f;
#pragma unroll
        for (int i = 0; i < 8; ++i) { yf[i] += yb[i]; s += yf[i]; }
        const float mean = red8(s) * (1.f / 64.f); float q = 0.f;
#pragma unroll
        for (int i = 0; i < 8; ++i) { yf[i] -= mean; q += yf[i] * yf[i]; }
        const float rstd = __builtin_amdgcn_rsqf(red8(q) * (1.f / 64.f) + eps64);
        u32x2 w; float o[8];
#pragma unroll
        for (int i = 0; i < 8; ++i) o[i] = (yf[i] * rstd * lg[i] + lb[i] + bo[i]) * ga[i];
        w.x = pk_fp8x4(o[0], o[1], o[2], o[3]); w.y = pk_fp8x4(o[4], o[5], o[6], o[7]);
        *(u32x2*)(YAB + (size_t)t * D + ch0) = w;
    }
}

DI float other_half(float x, int h) { const u32x2 r = __builtin_amdgcn_permlane32_swap(__builtin_bit_cast(unsigned, x), __builtin_bit_cast(unsigned, x), false, false); return __builtin_bit_cast(float, h ? r.x : r.y); }
DI int crow(int reg, int h) { return (reg & 3) + 8 * (reg >> 2) + 4 * h; }
DI bf16x8 pack_step(const f32x16& x, int s) {
    u32x4 p;
    asm volatile("s_nop 1\n\tv_cvt_pk_bf16_f32 %0, %4, %5\n\tv_cvt_pk_bf16_f32 %1, %6, %7\n\tv_cvt_pk_bf16_f32 %2, %8, %9\n\tv_cvt_pk_bf16_f32 %3, %10, %11\n\ts_nop 1"
                 : "=&v"(p[0]), "=&v"(p[1]), "=&v"(p[2]), "=&v"(p[3])
                 : "v"(x[8 * s]), "v"(x[8 * s + 1]), "v"(x[8 * s + 2]), "v"(x[8 * s + 3]), "v"(x[8 * s + 4]), "v"(x[8 * s + 5]), "v"(x[8 * s + 6]), "v"(x[8 * s + 7]));
    return __builtin_bit_cast(bf16x8, p);
}
DI int t5_bucket(int rel) {
    int n = -rel; const int ret = n < 0 ? 16 : 0; n = n < 0 ? -n : n;
    const int m = (n >= 12) + (n >= 16) + (n >= 23) + (n >= 32) + (n >= 46) + (n >= 64) + (n >= 91);
    return ret + (n < 8 ? n : 8 + m);
}
constexpr int KS_STRIDE = 72, VT_STRIDE = 392;
constexpr int A_KS = 0, A_VT = 384 * KS_STRIDE * 2, A_BIAS = A_VT + 64 * VT_STRIDE * 2, A_END = A_BIAS + 8 * 260 * 4;
static_assert(A_END <= RING_BYTES, "attention LDS");
DI void phase_attn(const Frame& F, int j) {
    const bf16_t* QKV = (const bf16_t*)(F.ws + WS_P); unsigned char* O = (unsigned char*)(F.ws + WS_YAB);
    LAS bf16_t* Ks = (LAS bf16_t*)(F.lds + A_KS); LAS bf16_t* Vt = (LAS bf16_t*)(F.lds + A_VT); LAS float* bT = (LAS float*)(F.lds + A_BIAS);
    const int r = F.lane & 31, h = F.lane >> 5; int kvh_tab = -1;
    for (int u = F.vcu; u < NB * 2 * 32; u += F.G) {
        const int qb = u & 31, kvh = (u >> 5) & 1, b = u >> 6; const int q0 = qb * 128;
        __syncthreads();
        {
            u32x4 kvr[6], vvr[6];
#pragma unroll
            for (int it = 0; it < 6; ++it) { const int cidx = F.tid + it * NTHR, key = cidx >> 3, part = cidx & 7, kp = q0 - 128 + key; const bool ok = kp >= 0 && kp < SEQ;
                const bf16_t* row = QKV + (size_t)(b * SEQ + (ok ? kp : q0)) * QKV_N + 1024 + kvh * 64 + part * 8; kvr[it] = *(const u32x4*)row; vvr[it] = *(const u32x4*)(row + 128);
                if (!ok) { kvr[it] = (u32x4){0u, 0u, 0u, 0u}; vvr[it] = (u32x4){0u, 0u, 0u, 0u}; } }
#pragma unroll
            for (int it = 0; it < 6; ++it) { const int cidx = F.tid + it * NTHR, key = cidx >> 3, part = cidx & 7;
                *(LAS u32x4*)(Ks + key * KS_STRIDE + part * 8) = kvr[it];
                const unsigned vw[4] = {vvr[it].x, vvr[it].y, vvr[it].z, vvr[it].w};
#pragma unroll
                for (int i = 0; i < 4; ++i) { Vt[(part * 8 + 2 * i) * VT_STRIDE + key] = (bf16_t)(vw[i] & 0xffffu); Vt[(part * 8 + 2 * i + 1) * VT_STRIDE + key] = (bf16_t)(vw[i] >> 16); } }
        }
        if (kvh != kvh_tab) for (int i = F.tid; i < 8 * 257; i += NTHR) { const int hh = i / 257, idx = i % 257; bT[hh * 260 + idx] = F.ap->in[29][t5_bucket(idx - 128) * 16 + kvh * 8 + hh] * 1.44269504f; }
        kvh_tab = kvh;
        __syncthreads();
        const int hh = F.wave, head = kvh * 8 + hh; const float sink = F.ap->in[27][j * 16 + head] * 1.44269504f;
        for (int sub = 0; sub < 4; ++sub) {
            const int qrel = 32 * sub + r;
            const size_t qrow = (size_t)(b * SEQ + q0 + qrel);
            bf16x8 Qf[4];
#pragma unroll
            for (int s = 0; s < 4; ++s) Qf[s] = *(const bf16x8*)(QKV + qrow * QKV_N + head * 64 + 16 * s + 8 * h);
            f32x16 O0, O1;
#pragma unroll
            for (int i = 0; i < 16; ++i) { O0[i] = 0.f; O1[i] = 0.f; }
            float mrun = sink, lrun = h ? 0.f : 1.f;
            for (int kt = sub; kt < sub + 9; ++kt) {
                f32x16 x;
#pragma unroll
                for (int i = 0; i < 16; ++i) x[i] = 0.f;
#pragma unroll
                for (int s = 0; s < 4; ++s) { const bf16x8 kf = *(const LAS bf16x8*)(Ks + (32 * kt + r) * KS_STRIDE + 16 * s + 8 * h);
                    x = __builtin_amdgcn_mfma_f32_32x32x16_bf16(kf, Qf[s], x, 0, 0, 0); }
                s16x4 vf[2][4];
#pragma unroll
                for (int s = 0; s < 2; ++s) { const int kc = 32 * kt + 16 * s + 4 * h;
                    vf[s][0] = *(const LAS s16x4*)(Vt + r * VT_STRIDE + kc); vf[s][1] = *(const LAS s16x4*)(Vt + r * VT_STRIDE + kc + 8);
                    vf[s][2] = *(const LAS s16x4*)(Vt + (32 + r) * VT_STRIDE + kc); vf[s][3] = *(const LAS s16x4*)(Vt + (32 + r) * VT_STRIDE + kc + 8); }
                __builtin_amdgcn_sched_barrier(0);
                float mt = -3.0e38f;
                if (kt > sub && kt < sub + 8 && qb > 0 && qb < 31) {
                    const LAS float* bp = bT + hh * 260 + 32 * kt - 32 * sub - r + 4 * h;
#pragma unroll
                    for (int i = 0; i < 16; ++i) { const float sc = x[i] * (0.125f * 1.44269504f) + bp[(i & 3) + 8 * (i >> 2)]; x[i] = sc; mt = fmaxf(mt, sc); }
                } else {
#pragma unroll
                for (int i = 0; i < 16; ++i) { const int kl = 32 * kt + crow(i, h); const int rel = kl - 128 - qrel; const int kp = q0 - 128 + kl;
                    const bool ok = rel >= -128 && rel <= 128 && kp >= 0 && kp < SEQ;
                    const int bi = rel < -128 ? 0 : (rel > 128 ? 256 : rel + 128);
                    const float sc = ok ? x[i] * (0.125f * 1.44269504f) + bT[hh * 260 + bi] : -1e30f; x[i] = sc; mt = fmaxf(mt, sc); }
                }
                mt = fmaxf(mt, other_half(mt, h));
                if (__builtin_amdgcn_ballot_w64(mt > mrun + 8.f) != 0) {
                    const float mnew = fmaxf(mrun, mt); const float alpha = __builtin_amdgcn_exp2f(mrun - mnew); lrun *= alpha; mrun = mnew;
#pragma unroll
                    for (int i = 0; i < 16; ++i) { O0[i] *= alpha; O1[i] *= alpha; } }
                float ps = 0.f;
#pragma unroll
                for (int i = 0; i < 16; ++i) { const float p = __builtin_amdgcn_exp2f(x[i] - mrun); x[i] = p; ps += p; }
                lrun += ps;
#pragma unroll
                for (int s = 0; s < 2; ++s) { const bf16x8 pf = pack_step(x, s);
                    const bf16x8 v0 = __builtin_shufflevector(vf[s][0], vf[s][1], 0, 1, 2, 3, 4, 5, 6, 7), v1 = __builtin_shufflevector(vf[s][2], vf[s][3], 0, 1, 2, 3, 4, 5, 6, 7);
                    O0 = __builtin_amdgcn_mfma_f32_32x32x16_bf16(v0, pf, O0, 0, 0, 0);
                    O1 = __builtin_amdgcn_mfma_f32_32x32x16_bf16(v1, pf, O1, 0, 0, 0); }
            }
            const float inv = __builtin_amdgcn_rcpf(lrun + other_half(lrun, h)); unsigned char* orow = O + qrow * D + head * 64;
#pragma unroll
            for (int g4 = 0; g4 < 4; ++g4) { const int d0 = 8 * g4 + 4 * h;
                *(unsigned*)(orow + d0) = pk_fp8x4(O0[4 * g4] * inv, O0[4 * g4 + 1] * inv, O0[4 * g4 + 2] * inv, O0[4 * g4 + 3] * inv);
                *(unsigned*)(orow + 32 + d0) = pk_fp8x4(O1[4 * g4] * inv, O1[4 * g4 + 1] * inv, O1[4 * g4 + 2] * inv, O1[4 * g4 + 3] * inv); }
        }
    }
}

#ifndef PHMASK
#define PHMASK 0xffff
#endif
#define PM(n) ((PHMASK >> (n)) & 1)
#ifndef REPMASK
#define REPMASK 0
#endif
#define REP(n) for (int rep_ = 0; rep_ < 1 + ((REPMASK >> (n)) & 1); ++rep_)
constexpr int PH_PER_LAYER = 16, PH_BASE = 2, N_PHASES = PH_BASE + DEPTH * PH_PER_LAYER;
__global__ void __launch_bounds__(NTHR, 2) fwd_kernel(Args args) {
    extern __shared__ __attribute__((aligned(16))) unsigned char lds_raw[];
    const int wv = __builtin_amdgcn_readfirstlane((int)threadIdx.x >> 6);
    Frame F = make_frame((LAS unsigned char*)lds_raw, wv);
    for (int u = F.tid; u < (LDS_BYTES - LDSCTL_OFF) / 4; u += NTHR) ((LAS unsigned*)(F.lds + LDSCTL_OFF))[u] = 0u;
    __syncthreads();
    const int lo = F.ap->ph_lo, hi = F.ap->ph_hi;
    unsigned* ctl = (unsigned*)(F.ws + WS_CTL);
    XcdBarrier bar; bar.bar = ctl + CW_BAR; bar.x = 0; bar.st = nullptr;
    if (hi - lo > 1) bar = xcd_barrier_post(ctl + CW_BAR, (volatile LAS unsigned*)(F.lds + L_MISC) + 8, F.tid == 0);
#define IN(k) (lo <= (k) && (k) < hi && ((F = make_frame((LAS unsigned char*)lds_raw, wv)), true))
#define SEAM(k) do { if ((k) + 1 < hi) xcd_barrier(bar, tid_now(wv) == 0); } while (0)
    const LAS int* tile_e = (const LAS int*)(F.lds + L_TILEE); const LAS int* ntl = (const LAS int*)(F.lds + L_NTILES);

    REP(0) if (PM(0)) if (IN(0)) { phase_prologue(F); SEAM(0); }
    REP(1) if (PM(1)) if (IN(1)) { phase_t0(F); SEAM(1); }
    for (int l = 0; l < DEPTH; ++l) {
        const int pb = PH_BASE + l * PH_PER_LAYER, j = l >> 1; const bool even = (l & 1) == 0;
        REP(2) if (PM(2)) if (IN(pb + 0)) {
            const int N = even ? AB_PROJ : QKV_N;
            const bf16_t* Bt = even ? (const bf16_t*)(F.ws + WS_WIN + (size_t)j * AB_PROJ * D) : (const bf16_t*)(F.ws + WS_WQKV + (size_t)j * QKV_N * D);
            pg8::Gemm g{(const bf16_t*)(F.ws + WS_H8), Bt, D / 2}; pg8::TileOrder S; S.init(T / 256, N / 256, F.G, (int)blockIdx.x, nullptr);
            pg8::EpiBf16<false> E{(bf16_t*)(F.ws + WS_P), N, nullptr, 0};
            pg8::gemm_phase<pg8::EpiBf16<false>, 2, true>(F.lds, F.tid, g, S, E);
            SEAM(pb + 0);
        }
        if (even) {
            REP(3) if (PM(3)) if (IN(pb + 1)) { phase_e3a(F, j); SEAM(pb + 1); }
            REP(4) if (PM(4)) if (IN(pb + 2)) {
                pg8::Gemm g{(const bf16_t*)(F.ws + WS_LIN), (const bf16_t*)(F.ws + WS_WLORA) + (size_t)j * LORA_N * LORA_K, LORA_K};
                pg8::TileOrder S; S.init(T / 256, LORA_N / 256, F.G, (int)blockIdx.x, nullptr);
                pg8::EpiBf16<false> E{(bf16_t*)(F.ws + WS_LO), LORA_N, nullptr, 0};
                pg8::gemm_phase<pg8::EpiBf16<false>>(F.lds, F.tid, g, S, E);
                SEAM(pb + 2);
            }
            REP(6) if (PM(6)) if (IN(pb + 4)) { phase_rsub(F, j); SEAM(pb + 4); }
            REP(7) if (PM(7)) if (IN(pb + 5)) { phase_chain(F); SEAM(pb + 5); }
            REP(8) if (PM(8)) if (IN(pb + 6)) { phase_fin(F, j); SEAM(pb + 6); }
        } else {
            REP(9) if (PM(9)) if (IN(pb + 1)) { phase_attn(F, j); SEAM(pb + 1); }
        }
        REP(10) if (PM(10)) if (IN(pb + 7)) {
            const bf16_t* Bt = even ? (const bf16_t*)(F.ws + WS_WOUT + (size_t)j * D * D) : (const bf16_t*)(F.ws + WS_WO + (size_t)j * D * D);
            pg8::Gemm g{(const bf16_t*)(F.ws + WS_YAB), Bt, D / 2}; pg8::TileOrder S; S.init(T / 256, D / 256, F.G, (int)blockIdx.x, nullptr);
            pg8::EpiBf16<false> E{(bf16_t*)(F.ws + WS_Y), D, nullptr, 0};
            pg8::gemm_phase<pg8::EpiBf16<false>, 2, true>(F.lds, F.tid, g, S, E);
            SEAM(pb + 7);
        }
        REP(11) if (PM(11)) if (IN(pb + 8)) { phase_tail(F, l); SEAM(pb + 8); }
        if (IN(pb + 9)) { phase_expert_weights(F, l, 0); SEAM(pb + 9); }
        REP(13) if (PM(13)) if (IN(pb + 10)) {
            moe_tables(F, l);
            pg8::Gemm g{(const bf16_t*)(F.ws + WS_H8), (const bf16_t*)(F.ws + WS_W1 + (size_t)l * NE * 2048 * D), D / 2};
            const pg8::GatherInfo GI{(const int*)(F.ws + WS_SLOTTOK), (const LAS int*)(F.lds + L_CNT), (const LAS int*)(F.lds + L_PSTART)};
            pg8::TileOrder S; S.init(__builtin_amdgcn_readfirstlane(ntl[0]), 2048 / 256, F.G, (int)blockIdx.x, tile_e);
            pg8::EpiSwiglu E{(unsigned char*)(F.ws + WS_A1), FF, (const float*)(F.ws + WS_B1P) + (size_t)l * NE * 2048, 2048};
            pg8::gemm_phase<pg8::EpiSwiglu, 1, true>(F.lds, F.tid, g, S, E, GI);
            SEAM(pb + 10);
        }
        if (IN(pb + 10)) { phase_expert_weights(F, l, 1); SEAM(pb + 10); }
        REP(14) if (PM(14)) if (IN(pb + 11)) {
            pg8::Gemm g{(const bf16_t*)(F.ws + WS_A1), (const bf16_t*)(F.ws + WS_W2 + (size_t)l * NE * D * FF), FF / 2};
            pg8::TileOrder S; S.init(__builtin_amdgcn_readfirstlane(ntl[0]), D / 256, F.G, (int)blockIdx.x, tile_e);
            pg8::EpiF8<true> E{(unsigned char*)(F.ws + WS_XS), D, F.ap->in[35] + (size_t)l * NE * D, D};
            pg8::gemm_phase<pg8::EpiF8<true>, 2, true, 0x7d7d7d7d>(F.lds, F.tid, g, S, E);
            SEAM(pb + 11);
        }
        REP(15) if (PM(15)) if (IN(pb + 12)) { phase_combine(F, l); if (l + 1 < DEPTH) SEAM(pb + 12); }
    }
#undef IN
#undef SEAM
}

#ifndef N_RUN_PHASES
#define N_RUN_PHASES N_PHASES
#endif
#ifndef ONE_LAUNCH
#define ONE_LAUNCH 1
#endif
extern "C" void kernel_launch(void* const* d_in, const int* in_sizes, int n_in, void* d_out, int out_size, void* d_ws, size_t ws_size, hipStream_t stream) {
    static int grid = 0;
    if (grid == 0) {
        if (n_in != 36 || out_size != T * D || ws_size < WS_END) { fprintf(stderr, "kernel_launch: unexpected sizes n_in %d out %d ws %zu (need %zu)\n", n_in, out_size, ws_size, (size_t)WS_END); grid = -1; return; }
        int dev = 0, cus = 0, per_cu = 0;
        if (hipGetDevice(&dev) != hipSuccess || hipDeviceGetAttribute(&cus, hipDeviceAttributeMultiprocessorCount, dev) != hipSuccess) { grid = -1; return; }
        if (hipFuncSetAttribute((const void*)fwd_kernel, hipFuncAttributeMaxDynamicSharedMemorySize, LDS_BYTES) != hipSuccess) { fprintf(stderr, "kernel_launch: hipFuncSetAttribute failed\n"); grid = -1; return; }
        if (hipOccupancyMaxActiveBlocksPerMultiprocessor(&per_cu, (const void*)fwd_kernel, NTHR, LDS_BYTES) != hipSuccess || per_cu < 1) { fprintf(stderr, "kernel_launch: occupancy query reports %d\n", per_cu); }
        (void)hipGetLastError();
        grid = cus;
    }
    if (grid < 0) return;
    (void)hipMemsetAsync((char*)d_ws + WS_CTL, 0, CTL_ZERO_BYTES, stream);
    Args a{};
    for (int i = 0; i < 36; ++i) a.in[i] = (const float*)d_in[i];
    a.out = (float*)d_out; a.ws = (unsigned char*)d_ws;
#if ONE_LAUNCH
    a.ph_lo = 0; a.ph_hi = N_RUN_PHASES;
    hipLaunchKernelGGL(fwd_kernel, dim3(grid), dim3(NTHR), LDS_BYTES, stream, a);
#else
    for (int k = 0; k < N_RUN_PHASES; ++k) {
        if (k >= PH_BASE) { const int l = (k - PH_BASE) / PH_PER_LAYER, p = (k - PH_BASE) % PH_PER_LAYER; if (p > 12 || p == 9 || p == 3) continue; if ((l & 1) && p >= 2 && p <= 6) continue; }
        a.ph_lo = k; a.ph_hi = k + 1;
        hipLaunchKernelGGL(fwd_kernel, dim3(grid), dim3(NTHR), LDS_BYTES, stream, a);
    }
#endif
}
```
